# Optimizing an MI355X kernel written in HIP

```python
import jax
import jax.numpy as jnp
from jax import lax
import numpy as np

D_MODEL = 1024
BATCH = 4
SEQ = 4096
DEPTH = 2

GRID_W = 64
CTX_LEN = 256
N_EVEN = (DEPTH + 1) // 2
N_ODD = DEPTH // 2
EPS = 1e-6
ROPE_BASE = 10000.0
CHUNK = 128
Q_BLOCK = 128

RET_HEADS = 8
RET_DK = 64
RET_DV = 64
RET_WIDTH = RET_HEADS * RET_DV
SSD_HEADS = 8
SSD_HEADDIM = 64
SSD_INNER = SSD_HEADS * SSD_HEADDIM
SSD_GROUPS = 2
SSD_STATE = 128
SSD_CONV = 5
CONV_CH = SSD_INNER + 2 * SSD_GROUPS * SSD_STATE
IN0_SPLITS = [RET_WIDTH, 2 * RET_WIDTH, 3 * RET_WIDTH, 4 * RET_WIDTH, 4 * RET_WIDTH + SSD_INNER, 4 * RET_WIDTH + SSD_INNER + CONV_CH]
IN0_WIDTH = 4 * RET_WIDTH + SSD_INNER + CONV_CH + 2 * SSD_HEADS
MIX0_WIDTH = RET_WIDTH + SSD_INNER
MLA_HEADS = 16
QK_NOPE = 64
QK_ROPE = 32
V_HEAD = 64
KV_RANK = 256
Q_RANK = 768
IN1_WIDTH = Q_RANK + KV_RANK + QK_ROPE
MLA_WIDTH = MLA_HEADS * V_HEAD
_FF_CEIL = -(-8 * D_MODEL // 3)
D_FF = -(-_FF_CEIL // 256) * 256

kernel_name = 'hybrid_retention_ssd_mla_prefix_dit'


def rms_norm(x, w=None):
    xf = x.astype(jnp.float32)
    y = xf * lax.rsqrt(jnp.mean(xf * xf, axis=-1, keepdims=True) + EPS)
    if w is not None:
        y = y * w.astype(jnp.float32)
    return y.astype(x.dtype)


def adaln_params(cond, w_ada, b_ada):
    m = jax.nn.silu(cond) @ w_ada + b_ada
    return jnp.split(m[:, None, :], 6, axis=-1)


def modulate(h, shift, scale):
    return h * (1 + scale) + shift


def axial_rope_tables(n_tok, rot_dim):
    rows = n_tok // GRID_W
    row = jnp.repeat(jnp.arange(rows), GRID_W).astype(jnp.float32)
    col = jnp.tile(jnp.arange(GRID_W), rows).astype(jnp.float32)
    n_freq = rot_dim // 4
    inv_freq = ROPE_BASE ** (-jnp.arange(n_freq, dtype=jnp.float32) / n_freq)
    ang = jnp.concatenate([row[:, None] * inv_freq, col[:, None] * inv_freq], axis=-1)
    return jnp.cos(ang), jnp.sin(ang)


def apply_rope(x, cos, sin):
    half = x.shape[-1] // 2
    x1 = x[..., :half].astype(jnp.float32)
    x2 = x[..., half:].astype(jnp.float32)
    c = cos[:, None, :]
    s = sin[:, None, :]
    return jnp.concatenate([x1 * c - x2 * s, x1 * s + x2 * c], axis=-1).astype(x.dtype)


def bhld(t):
    return jnp.transpose(t, (0, 2, 1, 3))


def depthwise_conv_centred(x, w, b):
    k = w.shape[0]
    y = lax.conv_general_dilated(x, w[:, None, :].astype(x.dtype), window_strides=(1,), padding=[(k // 2, k // 2)],
                                 dimension_numbers=('NWC', 'WIO', 'NWC'), feature_group_count=x.shape[-1])
    return y + b


def chunked_decay_scan(q, k, v, log_a, s0):
    b, h, l, dk = q.shape
    dv = v.shape[-1]
    n = l // CHUNK
    qc = q.astype(jnp.float32).reshape(b, h, n, CHUNK, dk)
    kc = k.astype(jnp.float32).reshape(b, h, n, CHUNK, dk)
    vc = v.astype(jnp.float32).reshape(b, h, n, CHUNK, dv)
    cum = jnp.cumsum(log_a.astype(jnp.float32).reshape(b, h, n, CHUNK), axis=-1)
    idx = jnp.arange(CHUNK)
    lower = idx[:, None] >= idx[None, :]
    decay = jnp.exp(jnp.where(lower, cum[..., :, None] - cum[..., None, :], -jnp.inf))
    scores = jnp.einsum('bhnid,bhnjd->bhnij', qc, kc) * decay
    y_intra = jnp.einsum('bhnij,bhnjv->bhniv', scores, vc)
    to_end = jnp.exp(cum[..., -1:] - cum)
    kv_chunk = jnp.einsum('bhnjd,bhnj,bhnjv->bhndv', kc, to_end, vc)
    total = jnp.exp(cum[..., -1])

    def step(s, inp):
        kv_n, tot_n = inp
        return tot_n[..., None, None] * s + kv_n, s

    s_final, s_before = lax.scan(step, s0, (jnp.moveaxis(kv_chunk, 2, 0), jnp.moveaxis(total, 2, 0)))
    s_before = jnp.moveaxis(s_before, 0, 2)
    y_inter = jnp.einsum('bhnid,bhni,bhndv->bhniv', qc, jnp.exp(cum), s_before)
    return (y_intra + y_inter).reshape(b, h, l, dv), s_final


def bidir_prefix_scan(ctx_in, lat_in):
    qc, kc, vfc, vbc, lafc, labc = ctx_in
    ql, kl, vfl, vbl, lafl, labl = lat_in
    b, h, _, dk = qc.shape
    dv = vfc.shape[-1]
    s0 = jnp.zeros((b, h, dk, dv), jnp.float32)
    flip = lambda t: jnp.flip(t, axis=2)
    yc_f, sc_f = chunked_decay_scan(qc, kc, vfc, lafc, s0)
    yc_b, sc_b = chunked_decay_scan(flip(qc), flip(kc), flip(vbc), flip(labc), s0)
    yl_f, _ = chunked_decay_scan(ql, kl, vfl, lafl, sc_f)
    yl_b, _ = chunked_decay_scan(flip(ql), flip(kl), flip(vbl), flip(labl), sc_b)

    def merge(q, k, vb, yf, yb):
        diag = jnp.einsum('bhld,bhld->bhl', q.astype(jnp.float32), k.astype(jnp.float32))[..., None] * vb.astype(jnp.float32)
        return (yf + flip(yb) - diag).astype(vb.dtype)

    return merge(qc, kc, vbc, yc_f, yc_b), merge(ql, kl, vbl, yl_f, yl_b)


def ret_ssd_project(h, w_in, conv_w, conv_b, dt_bias, a_log, decay_logit, rope):
    b, l, _ = h.shape
    q, k, v, g, z, xbc, dt_raw = jnp.split(h @ w_in, IN0_SPLITS, axis=-1)
    q = q.reshape(b, l, RET_HEADS, RET_DK)
    k = k.reshape(b, l, RET_HEADS, RET_DK) * (RET_DK ** -0.5)
    if rope is not None:
        q = apply_rope(q, *rope)
        k = apply_rope(k, *rope)
    v = v.reshape(b, l, RET_HEADS, RET_DV)
    ret_la = jax.nn.log_sigmoid(decay_logit.astype(jnp.float32))
    la_r = [jnp.broadcast_to(ret_la[d][None, :, None], (b, RET_HEADS, l)) for d in range(2)]
    ret_in = (bhld(q), bhld(k), bhld(v), bhld(v), la_r[0], la_r[1])
    xbc = jax.nn.silu(depthwise_conv_centred(xbc, conv_w, conv_b))
    xs, bm, cm = jnp.split(xbc, [SSD_INNER, SSD_INNER + SSD_GROUPS * SSD_STATE], axis=-1)
    xs = xs.reshape(b, l, SSD_HEADS, SSD_HEADDIM)
    rep = SSD_HEADS // SSD_GROUPS
    bm = jnp.repeat(bm.reshape(b, l, SSD_GROUPS, SSD_STATE), rep, axis=2)
    cm = jnp.repeat(cm.reshape(b, l, SSD_GROUPS, SSD_STATE), rep, axis=2)
    dt = jax.nn.softplus(dt_raw.astype(jnp.float32).reshape(b, l, 2, SSD_HEADS) + dt_bias.astype(jnp.float32))
    log_a = dt * (-jnp.exp(a_log.astype(jnp.float32)))
    v_f = xs * dt[:, :, 0, :, None].astype(xs.dtype)
    v_b = xs * dt[:, :, 1, :, None].astype(xs.dtype)
    ssd_in = (bhld(cm), bhld(bm), bhld(v_f), bhld(v_b),
              jnp.transpose(log_a[:, :, 0], (0, 2, 1)), jnp.transpose(log_a[:, :, 1], (0, 2, 1)))
    return ret_in, ssd_in, g, z, xs


def retention_ssd_mixer(a_ctx, a_lat, w_in, conv_w, conv_b, dt_bias, a_log, d_skip, ssd_norm_w,
                        decay_logit, gn_w, w_out, rope, need_ctx):
    pc = ret_ssd_project(a_ctx, w_in, conv_w, conv_b, dt_bias, a_log, decay_logit, None)
    pl = ret_ssd_project(a_lat, w_in, conv_w, conv_b, dt_bias, a_log, decay_logit, rope)
    ret_c, ret_l = bidir_prefix_scan(pc[0], pl[0])
    ssd_c, ssd_l = bidir_prefix_scan(pc[1], pl[1])

    def finish(proj, y_ret, y_ssd):
        _, _, g, z, xs = proj
        b, l = g.shape[:2]
        yr = bhld(y_ret).astype(jnp.float32)
        mu = jnp.mean(yr, axis=-1, keepdims=True)
        var = jnp.mean(jnp.square(yr - mu), axis=-1, keepdims=True)
        yr = ((yr - mu) * lax.rsqrt(var + EPS)).reshape(b, l, RET_WIDTH) * gn_w.astype(jnp.float32)
        yr = yr.astype(g.dtype) * jax.nn.silu(g)
        ys = bhld(y_ssd) + d_skip[:, None] * xs
        ys = rms_norm(ys.reshape(b, l, SSD_INNER) * jax.nn.silu(z), ssd_norm_w)
        return jnp.concatenate([yr, ys], axis=-1) @ w_out

    out_l = finish(pl, ret_l, ssd_l)
    out_c = finish(pc, ret_c, ssd_c) if need_ctx else None
    return out_c, out_l


def mla_project(h, w_in, q_norm_w, w_uq, kv_norm_w, w_ukv, rope):
    b, l, _ = h.shape
    c_q, c_kv, k_pe = jnp.split(h @ w_in, [Q_RANK, Q_RANK + KV_RANK], axis=-1)
    q = (rms_norm(c_q, q_norm_w) @ w_uq).reshape(b, l, MLA_HEADS, QK_NOPE + QK_ROPE)
    q_nope, q_pe = jnp.split(q, [QK_NOPE], axis=-1)
    kv = (rms_norm(c_kv, kv_norm_w) @ w_ukv).reshape(b, l, MLA_HEADS, QK_NOPE + V_HEAD)
    k_nope, v = jnp.split(kv, [QK_NOPE], axis=-1)
    k_pe = k_pe[:, :, None, :]
    if rope is not None:
        q_pe = apply_rope(q_pe, *rope)
        k_pe = apply_rope(k_pe, *rope)
    q = jnp.concatenate([q_nope, q_pe], axis=-1)
    k = jnp.concatenate([k_nope, jnp.broadcast_to(k_pe, (b, l, MLA_HEADS, QK_ROPE))], axis=-1)
    return q, k, v


def softmax_attention(q, k, v):
    s = jnp.einsum('bqhd,bkhd->bhqk', q, k).astype(jnp.float32) * ((QK_NOPE + QK_ROPE) ** -0.5)
    p = jax.nn.softmax(s, axis=-1)
    return jnp.einsum('bhqk,bkhd->bqhd', p.astype(v.dtype), v)


def mla_mixer(a_ctx, a_lat, w_in, q_norm_w, w_uq, kv_norm_w, w_ukv, w_out, rope, need_ctx):
    q_c, k_c, v_c = mla_project(a_ctx, w_in, q_norm_w, w_uq, kv_norm_w, w_ukv, None)
    q_l, k_l, v_l = mla_project(a_lat, w_in, q_norm_w, w_uq, kv_norm_w, w_ukv, rope)
    k_all = jnp.concatenate([k_c, k_l], axis=1)
    v_all = jnp.concatenate([v_c, v_l], axis=1)
    b, l = a_lat.shape[:2]
    nb = l // Q_BLOCK
    q_blocks = jnp.moveaxis(q_l.reshape(b, nb, Q_BLOCK, MLA_HEADS, QK_NOPE + QK_ROPE), 1, 0)
    o_l = lax.map(lambda qb: softmax_attention(qb, k_all, v_all), q_blocks)
    out_l = jnp.moveaxis(o_l, 0, 1).reshape(b, l, MLA_WIDTH) @ w_out
    out_c = None
    if need_ctx:
        out_c = softmax_attention(q_c, k_c, v_c).reshape(b, a_ctx.shape[1], MLA_WIDTH) @ w_out
    return out_c, out_l


def swiglu(h, w_gate, w_up, w_down):
    return (jax.nn.silu(h @ w_gate) * (h @ w_up)) @ w_down


def setup_inputs(seed: int = 0) -> dict:
    key = jax.random.key(seed)
    ks = iter(jax.random.split(key, 40))
    f32 = jnp.float32

    def normal(shape, scale=1.0):
        return scale * jax.random.normal(next(ks), shape, f32)

    def dense(shape):
        return normal(shape, shape[-2] ** -0.5)

    def gain(shape):
        return 1.0 + normal(shape, 0.02)

    gammas = 1.0 - 2.0 ** (-5.0 - np.arange(RET_HEADS))
    base_logit = jnp.asarray(np.log(gammas / (1.0 - gammas)), dtype=f32)
    dt0 = jnp.exp(jax.random.uniform(next(ks), (N_EVEN, 2, SSD_HEADS), f32, np.log(1e-3), np.log(1e-1)))
    return {
        'x': normal((BATCH, SEQ, D_MODEL)),
        'c': normal((BATCH, D_MODEL)),
        'ctx': normal((BATCH, CTX_LEN, D_MODEL)),
        'c_ctx': normal((D_MODEL,)),
        'w_ada': dense((DEPTH, D_MODEL, 6 * D_MODEL)),
        'b_ada': normal((DEPTH, 6 * D_MODEL), 0.02),
        'w_ffn_gate': dense((DEPTH, D_MODEL, D_FF)),
        'w_ffn_up': dense((DEPTH, D_MODEL, D_FF)),
        'w_ffn_down': dense((DEPTH, D_FF, D_MODEL)),
        'ret_ssd_w_in': dense((N_EVEN, D_MODEL, IN0_WIDTH)),
        'ssd_conv_w': dense((N_EVEN, SSD_CONV, CONV_CH)),
        'ssd_conv_b': normal((N_EVEN, CONV_CH), 0.02),
        'ssd_dt_bias': dt0 + jnp.log(-jnp.expm1(-dt0)),
        'ssd_a_log': jnp.log(jax.random.uniform(next(ks), (N_EVEN, 2, SSD_HEADS), f32, 1.0, 16.0)),
        'ssd_d': gain((N_EVEN, SSD_HEADS)),
        'ssd_norm_w': gain((N_EVEN, SSD_INNER)),
        'ret_decay_logit': base_logit + normal((N_EVEN, 2, RET_HEADS), 0.1),
        'ret_gn_w': gain((N_EVEN, RET_WIDTH)),
        'ret_ssd_w_out': dense((N_EVEN, MIX0_WIDTH, D_MODEL)),
        'mla_w_in': dense((N_ODD, D_MODEL, IN1_WIDTH)),
        'mla_q_norm_w': gain((N_ODD, Q_RANK)),
        'mla_w_uq': dense((N_ODD, Q_RANK, MLA_HEADS * (QK_NOPE + QK_ROPE))),
        'mla_kv_norm_w': gain((N_ODD, KV_RANK)),
        'mla_w_ukv': dense((N_ODD, KV_RANK, MLA_HEADS * (QK_NOPE + V_HEAD))),
        'mla_w_out': dense((N_ODD, MLA_WIDTH, D_MODEL)),
        'final_norm_w': gain((D_MODEL,)),
    }


def reference(x, c, ctx, c_ctx, w_ada, b_ada, w_ffn_gate, w_ffn_up, w_ffn_down,
              ret_ssd_w_in, ssd_conv_w, ssd_conv_b, ssd_dt_bias, ssd_a_log, ssd_d, ssd_norm_w,
              ret_decay_logit, ret_gn_w, ret_ssd_w_out,
              mla_w_in, mla_q_norm_w, mla_w_uq, mla_kv_norm_w, mla_w_ukv, mla_w_out, final_norm_w):
    lat_len = x.shape[1]
    rope_ret = axial_rope_tables(lat_len, RET_DK)
    rope_mla = axial_rope_tables(lat_len, QK_ROPE)
    h_ctx, h_lat = ctx, x
    for i in range(DEPTH):
        last = i == DEPTH - 1
        j = i // 2
        m_lat = adaln_params(c, w_ada[i], b_ada[i])
        m_ctx = adaln_params(c_ctx[None], w_ada[i], b_ada[i])
        a_ctx = modulate(rms_norm(h_ctx), m_ctx[0], m_ctx[1])
        a_lat = modulate(rms_norm(h_lat), m_lat[0], m_lat[1])
        if i % 2 == 0:
            o_ctx, o_lat = retention_ssd_mixer(a_ctx, a_lat, ret_ssd_w_in[j], ssd_conv_w[j], ssd_conv_b[j],
                                               ssd_dt_bias[j], ssd_a_log[j], ssd_d[j], ssd_norm_w[j],
                                               ret_decay_logit[j], ret_gn_w[j], ret_ssd_w_out[j], rope_ret, not last)
        else:
            o_ctx, o_lat = mla_mixer(a_ctx, a_lat, mla_w_in[j], mla_q_norm_w[j], mla_w_uq[j], mla_kv_norm_w[j],
                                     mla_w_ukv[j], mla_w_out[j], rope_mla, not last)
        h_lat = h_lat + m_lat[2] * o_lat
        h_lat = h_lat + m_lat[5] * swiglu(modulate(rms_norm(h_lat), m_lat[3], m_lat[4]),
                                          w_ffn_gate[i], w_ffn_up[i], w_ffn_down[i])
        if not last:
            h_ctx = h_ctx + m_ctx[2] * o_ctx
            h_ctx = h_ctx + m_ctx[5] * swiglu(modulate(rms_norm(h_ctx), m_ctx[3], m_ctx[4]),
                                              w_ffn_gate[i], w_ffn_up[i], w_ffn_down[i])
    return rms_norm(h_lat, final_norm_w)
```

```cpp
#include <hip/hip_runtime.h>
#include <hip/hip_cooperative_groups.h>
#include <cstdio>
#include <cmath>
namespace cg = cooperative_groups;

#ifndef PHASE_MASK
#define PHASE_MASK 0xFFFFF
#endif
#ifndef SINGLE_LAUNCH
#define SINGLE_LAUNCH 1
#endif

typedef unsigned short bf16_t;
typedef short bf16x8 __attribute__((ext_vector_type(8)));
typedef float f32x16 __attribute__((ext_vector_type(16)));
typedef float f32x4 __attribute__((ext_vector_type(4)));
typedef unsigned u32x4 __attribute__((ext_vector_type(4)));
typedef unsigned u32x2 __attribute__((ext_vector_type(2)));

constexpr int DM = 1024, NBATCH = 4, SEQL = 4096, CTXL = 256;
constexpr int NCTX = NBATCH * CTXL;
constexpr int NLAT = NBATCH * SEQL;
constexpr int NTOK = NCTX + NLAT;
constexpr int DFF = 2816;
constexpr int P0W = 3584;
constexpr int CQW = 1056;
constexpr int NKEY = CTXL + SEQL;
constexpr int NCHUNK = 34;
constexpr int NITEM = NBATCH * NCHUNK * 16;
constexpr float EPS = 1e-6f;
constexpr int NPHASE = 20;

struct Params {
    const float *x, *c, *ctx, *c_ctx, *w_ada, *b_ada, *w_gate, *w_up, *w_down, *w_in0, *conv_w, *conv_b, *dt_bias, *a_log,
        *ssd_d, *ssd_norm_w, *decay_logit, *gn_w, *w_out0, *mla_w_in, *q_norm_w, *w_uq, *kv_norm_w, *w_ukv, *mla_w_out, *final_norm_w;
    float* out;
    bf16_t *wt_in0, *wt_out0, *wt_f1_0, *wt_f2_0;
    bf16_t *wt_mla_in, *wt_uq, *wt_ukv, *wt_mla_out, *wt_f1_1, *wt_f2_1;
    bf16_t *big, *abuf, *st_ret, *st_ssd, *kpe;
    float *hctx, *ada, *rope_ret, *rope_mla, *dt_raw, *dtv, *la, *tot; unsigned* bar;
    float inv_ret[16];
    float inv_mla[8];
};

typedef float f32x2 __attribute__((ext_vector_type(2)));
typedef __bf16 bf16x2_t __attribute__((ext_vector_type(2)));
__device__ __forceinline__ unsigned pack_bf16(float lo, float hi) {
    f32x2 v = {lo, hi};
    union { bf16x2_t b; unsigned u; } x; x.b = __builtin_convertvector(v, bf16x2_t); return x.u;
}
__device__ __forceinline__ bf16_t f2bf(float v) { return (bf16_t)(pack_bf16(v, 0.f) & 0xffffu); }
__device__ __forceinline__ float bf_lo(unsigned u) { return __uint_as_float(u << 16); }
__device__ __forceinline__ float bf_hi(unsigned u) { return __uint_as_float(u & 0xffff0000u); }
__device__ __forceinline__ float bf2f(bf16_t h) { return __uint_as_float(((unsigned)h) << 16); }
__device__ __forceinline__ float silu_f(float v) { return v * __builtin_amdgcn_rcpf(1.0f + __expf(-v)); }
__device__ __forceinline__ float wave_sum(float v) {
    v += __shfl_xor(v, 32); v += __shfl_xor(v, 16); v += __shfl_xor(v, 8);
    v += __shfl_xor(v, 4);  v += __shfl_xor(v, 2);  v += __shfl_xor(v, 1);
    return v;
}
__device__ __forceinline__ f32x16 mfma32(bf16x8 a, bf16x8 b, f32x16 c) { return __builtin_amdgcn_mfma_f32_32x32x16_bf16(a, b, c, 0, 0, 0); }
__device__ __forceinline__ bf16x8 as_bf16x8(u32x4 v) { union { u32x4 u; bf16x8 b; } x; x.u = v; return x.b; }
__device__ __forceinline__ int cond_of_row(int row) { return row < NCTX ? 4 : ((row - NCTX) >> 12); }
__device__ __forceinline__ int crow(int r, int lh) { return (r & 3) + 8 * (r >> 2) + 4 * lh; }


#define XB_TMO      128
#define XB_XCNT(j)  (256  + 64 * (j))
#define XB_XSUB(j)  (1280 + 64 * (j))
#define XB_XGEN(j)  (2304 + 64 * (j))
#define XB_TOP      3328
#define XB_TOPGEN   3392
#define XCD_BAR_WORDS 3456
#define XB_SPIN_CAP (1u << 22)
#define LAS __attribute__((address_space(3)))
__device__ __forceinline__ unsigned xb_ld(unsigned* p)              { return __hip_atomic_load(p, __ATOMIC_RELAXED, __HIP_MEMORY_SCOPE_AGENT); }
__device__ __forceinline__ unsigned xb_add(unsigned* p, unsigned v) { return __hip_atomic_fetch_add(p, v, __ATOMIC_RELAXED, __HIP_MEMORY_SCOPE_AGENT); }
__device__ __forceinline__ unsigned xb_xcc_id() { return (unsigned)__builtin_amdgcn_s_getreg((3 << 11) | 20) & 0xFu; }
#define XB_SPIN(cond, bar) do { unsigned _sp = 0; while (cond) { __builtin_amdgcn_s_sleep(1); \
    if ((++_sp & 255u) == 0u) { if (xb_ld(&(bar)[XB_TMO])) break; if (_sp > XB_SPIN_CAP) { atomicAdd(&(bar)[XB_TMO], 1u); break; } } } } while (0)
struct XcdBarrier { unsigned* bar; unsigned x; volatile unsigned* st; };
__device__ __forceinline__ XcdBarrier xcd_barrier_post(unsigned* bar, volatile unsigned* st) {
    XcdBarrier b; b.bar = bar; b.x = xb_xcc_id(); b.st = st;
    if (threadIdx.x == 0) (void)xb_add(&bar[XB_XCNT(b.x)], 1u);
    return b;
}
__device__ __forceinline__ void xcd_barrier_complete(unsigned* bar, unsigned x, unsigned& nloc, unsigned& nx) {
    const unsigned G = gridDim.x * gridDim.y * gridDim.z;
    unsigned sum, cnt, mine, sp = 0u;
    for (;;) {
        sum = 0u; cnt = 0u; mine = 0u;
#pragma unroll
        for (unsigned j = 0; j < 16; ++j) { const unsigned c = xb_ld(&bar[XB_XCNT(j)]); sum += c; cnt += (c > 0u) ? 1u : 0u; mine = (j == x) ? c : mine; }
        if (sum == G) break;
        __builtin_amdgcn_s_sleep(1);
        if ((++sp & 255u) == 0u) { if (xb_ld(&bar[XB_TMO])) break; if (sp > XB_SPIN_CAP) { atomicAdd(&bar[XB_TMO], 1u); break; } }
    }
    nloc = mine > 0u ? mine : 1u; nx = cnt > 0u ? cnt : 1u;
}
__device__ __forceinline__ void xcd_barrier(const XcdBarrier& b) {
    asm volatile("s_waitcnt vmcnt(0)" ::: "memory");
    __syncthreads();
    if (threadIdx.x == 0) {
        unsigned* bar = b.bar;
        __builtin_amdgcn_s_waitcnt(0);
        unsigned nloc = b.st[0], nx = b.st[1];
        if (nloc == 0u) { xcd_barrier_complete(bar, b.x, nloc, nx); b.st[0] = nloc; b.st[1] = nx; }
        const unsigned old = xb_add(&bar[XB_XSUB(b.x)], 1u);
        const unsigned gen = old / nloc;
        if (old + 1u == (gen + 1u) * nloc) {
            __builtin_amdgcn_fence(__ATOMIC_RELEASE, "agent");
            asm volatile("s_waitcnt vmcnt(0)" ::: "memory");
            const unsigned og = xb_add(&bar[XB_TOP], 1u);
            const unsigned tg = og / nx;
            if (og + 1u == (tg + 1u) * nx) xb_add(&bar[XB_TOPGEN], 1u);
            else XB_SPIN(xb_ld(&bar[XB_TOPGEN]) == tg, bar);
            __builtin_amdgcn_fence(__ATOMIC_ACQUIRE, "agent");
            xb_add(&bar[XB_XGEN(b.x)], 1u);
            asm volatile("s_waitcnt vmcnt(0)" ::: "memory");
        } else {
            XB_SPIN(xb_ld(&bar[XB_XGEN(b.x)]) == gen, bar);
            __builtin_amdgcn_fence(__ATOMIC_ACQUIRE, "agent");
            asm volatile("s_waitcnt vmcnt(0)" ::: "memory");
        }
    }
    __syncthreads();
}

struct WJob { const float* src; const float* src2; const float* kscale; bf16_t* dst; int K, Nsrc, Ndst, mode; };
__device__ __forceinline__ void wconv_tile(const WJob& j, int tk, int tn, char* smem) {
    float* sm = (float*)smem;
    const int t = threadIdx.x;
#pragma unroll
    for (int i = 0; i < 4; ++i) {
        const int kl = (t >> 4) + 16 * i, nq = (t & 15) * 4;
        const int np = tn * 64 + nq, kp = tk * 64 + kl;
        int row = kp, col = np; const float* arr = j.src; bool valid = true; float sc = 1.0f;
        if (j.mode == 0) {
            if (np >= 1536 && np < 2048) col = np + 512; else if (np >= 2048 && np < 2560) col = np - 512;
            if (np >= 3600) valid = false;
        } else if (j.mode == 1) {
            row = kp < 512 ? kp + 512 : kp - 512;
            if (kp < 512) sc = j.kscale[kp];
        } else if (j.mode == 2) {
            const int t128 = np >> 7, wn = (np >> 6) & 1, half = (np >> 5) & 1, cc = np & 31;
            col = t128 * 64 + wn * 32 + cc; arr = half ? j.src2 : j.src;
        } else {
            if (np >= j.Nsrc) valid = false;
            if (j.kscale) sc = j.kscale[kp];
        }
        f32x4 v = {0.f, 0.f, 0.f, 0.f};
        if (valid) v = *(const f32x4*)(arr + (size_t)row * j.Nsrc + col);
        sm[kl * 65 + nq + 0] = v[0] * sc; sm[kl * 65 + nq + 1] = v[1] * sc; sm[kl * 65 + nq + 2] = v[2] * sc; sm[kl * 65 + nq + 3] = v[3] * sc;
    }
    __syncthreads();
    {
        const int nl = t >> 2, ks = (t & 3) * 16;
        unsigned w[8];
#pragma unroll
        for (int e = 0; e < 8; ++e) w[e] = pack_bf16(sm[(ks + 2 * e) * 65 + nl], sm[(ks + 2 * e + 1) * 65 + nl]);
        bf16_t* d = j.dst + (size_t)(tn * 64 + nl) * j.K + tk * 64 + ks;
        *(u32x4*)d = (u32x4){w[0], w[1], w[2], w[3]};
        *(u32x4*)(d + 8) = (u32x4){w[4], w[5], w[6], w[7]};
    }
    __syncthreads();
}
__device__ __forceinline__ void mk_job(WJob& j, const float* src, const float* src2, const float* ks, bf16_t* dst, int K, int Nsrc, int Ndst, int mode) {
    j.src = src; j.src2 = src2; j.kscale = ks; j.dst = dst; j.K = K; j.Nsrc = Nsrc; j.Ndst = Ndst; j.mode = mode;
}
constexpr int WC0_TILES = 928 + 256 + 1408 + 704;
constexpr int WC1_TILES = 288 + 288 + 128 + 256 + 1408 + 704;
__device__ __forceinline__ void wconv_item(const Params& p, int set, int idx, char* smem) {
    WJob j;
    if (set == 0) {
        if (idx < 928) mk_job(j, p.w_in0, nullptr, nullptr, p.wt_in0, 1024, 3600, 3712, 0);
        else if ((idx -= 928) < 256) mk_job(j, p.w_out0, nullptr, p.ssd_norm_w, p.wt_out0, 1024, 1024, 1024, 1);
        else if ((idx -= 256) < 1408) mk_job(j, p.w_gate, p.w_up, nullptr, p.wt_f1_0, 1024, 2816, 5632, 2);
        else { idx -= 1408; mk_job(j, p.w_down, nullptr, nullptr, p.wt_f2_0, 2816, 1024, 1024, 3); }
    } else {
        if (idx < 288) mk_job(j, p.mla_w_in, nullptr, nullptr, p.wt_mla_in, 1024, 1056, 1152, 3);
        else if ((idx -= 288) < 288) mk_job(j, p.w_uq, nullptr, p.q_norm_w, p.wt_uq, 768, 1536, 1536, 3);
        else if ((idx -= 288) < 128) mk_job(j, p.w_ukv, nullptr, p.kv_norm_w, p.wt_ukv, 256, 2048, 2048, 3);
        else if ((idx -= 128) < 256) mk_job(j, p.mla_w_out, nullptr, nullptr, p.wt_mla_out, 1024, 1024, 1024, 3);
        else if ((idx -= 256) < 1408) mk_job(j, p.w_gate + (size_t)1024 * 2816, p.w_up + (size_t)1024 * 2816, nullptr, p.wt_f1_1, 1024, 2816, 5632, 2);
        else { idx -= 1408; mk_job(j, p.w_down + (size_t)2816 * 1024, nullptr, nullptr, p.wt_f2_1, 2816, 1024, 1024, 3); }
    }
    const int nkt = j.K / 64;
    wconv_tile(j, idx % nkt, idx / nkt, smem);
}

__device__ __forceinline__ void adaln_item(const Params& p, int a, char* smem) {
    float* sc = (float*)smem;
    float* red = sc + 5 * 1024;
    const int t = threadIdx.x;
    const int layer = a / 192, cb = a % 192;
    for (int i = t; i < 5 * 1024; i += 256) {
        const int cnd = i >> 10, k = i & 1023;
        const float v = cnd < 4 ? p.c[cnd * 1024 + k] : p.c_ctx[k];
        sc[i] = silu_f(v);
    }
    __syncthreads();
    const int kq = t >> 3, cq = t & 7;
    const int col = cb * 32 + cq * 4;
    float acc[5][4];
#pragma unroll
    for (int cnd = 0; cnd < 5; ++cnd) { acc[cnd][0] = acc[cnd][1] = acc[cnd][2] = acc[cnd][3] = 0.f; }
    const float* wp = p.w_ada + (size_t)layer * 1024 * 6144 + col;
#pragma unroll 4
    for (int kk = 0; kk < 32; ++kk) {
        const int k = kq + 32 * kk;
        const f32x4 w = *(const f32x4*)(wp + (size_t)k * 6144);
#pragma unroll
        for (int cnd = 0; cnd < 5; ++cnd) {
            const float s = sc[cnd * 1024 + k];
            acc[cnd][0] += s * w[0]; acc[cnd][1] += s * w[1]; acc[cnd][2] += s * w[2]; acc[cnd][3] += s * w[3];
        }
    }
#pragma unroll
    for (int cnd = 0; cnd < 5; ++cnd)
#pragma unroll
        for (int e = 0; e < 4; ++e) red[(kq * 8 + cq) * 20 + cnd * 4 + e] = acc[cnd][e];
    __syncthreads();
    if (t < 160) {
        const int cnd = t >> 5, cl = t & 31;
        float s = p.b_ada[layer * 6144 + cb * 32 + cl];
        for (int q = 0; q < 32; ++q) s += red[(q * 8 + (cl >> 2)) * 20 + cnd * 4 + (cl & 3)];
        p.ada[(size_t)(layer * 5 + cnd) * 6144 + cb * 32 + cl] = s;
    }
    __syncthreads();
}

__device__ __forceinline__ void sincos_acc(float xf, float& s, float& c) {
    const double x = (double)xf;
    const double k = rint(x * 0.63661977236758134308);
    const double r = x - k * 1.57079632679489661923;
    const double r2 = r * r;
    double sp = r * (1.0 + r2 * (-1.0 / 6 + r2 * (1.0 / 120 + r2 * (-1.0 / 5040 + r2 * (1.0 / 362880 + r2 * (-1.0 / 39916800 + r2 * (1.0 / 6227020800.0)))))));
    double cp = 1.0 + r2 * (-0.5 + r2 * (1.0 / 24 + r2 * (-1.0 / 720 + r2 * (1.0 / 40320 + r2 * (-1.0 / 3628800 + r2 * (1.0 / 479001600.0 + r2 * (-1.0 / 87178291200.0)))))));
    const int q = ((int)k) & 3;
    double ss, cc;
    if (q == 0) { ss = sp; cc = cp; } else if (q == 1) { ss = cp; cc = -sp; } else if (q == 2) { ss = -sp; cc = -cp; } else { ss = -cp; cc = sp; }
    s = (float)ss; c = (float)cc;
}
__device__ __forceinline__ void rope_item(const Params& p) {
    for (int i = threadIdx.x; i < 1024 + 512; i += 256) {
        float s, c;
        if (i < 1024) { const int pos = i >> 4, f = i & 15; sincos_acc((float)pos * p.inv_ret[f], s, c); p.rope_ret[i] = c; p.rope_ret[1024 + i] = s; }
        else { const int ii = i - 1024, pos = ii >> 3, f = ii & 7; sincos_acc((float)pos * p.inv_mla[f], s, c); p.rope_mla[ii] = c; p.rope_mla[512 + ii] = s; }
    }
}

__device__ __forceinline__ void norm_mod_phase(const Params& p, int src_mode, int layer, int shift_chunk, int row0, int row1) {
    const int lane = threadIdx.x & 63, w = threadIdx.x >> 6;
    for (int row = row0 + blockIdx.x * 4 + w; row < row1; row += gridDim.x * 4) {
        const float* src;
        if (row < NCTX) src = (src_mode == 0 ? p.ctx : p.hctx) + (size_t)row * DM;
        else src = (src_mode == 0 ? p.x : p.out) + (size_t)(row - NCTX) * DM;
        f32x4 v[4]; float ss = 0.f;
#pragma unroll
        for (int i = 0; i < 4; ++i) { v[i] = *(const f32x4*)(src + (lane + 64 * i) * 4); ss += v[i][0] * v[i][0] + v[i][1] * v[i][1] + v[i][2] * v[i][2] + v[i][3] * v[i][3]; }
        ss = wave_sum(ss);
        const float r = rsqrtf(ss * (1.0f / DM) + EPS);
        const float* ad = p.ada + (size_t)(layer * 5 + cond_of_row(row)) * 6144;
        const float* shp = ad + shift_chunk * 1024;
        const float* scp = ad + (shift_chunk + 1) * 1024;
        bf16_t* dst = p.abuf + (size_t)row * DM;
        f32x4 sh[4], sc[4];
#pragma unroll
        for (int i = 0; i < 4; ++i) { sh[i] = *(const f32x4*)(shp + (lane + 64 * i) * 4); sc[i] = *(const f32x4*)(scp + (lane + 64 * i) * 4); }
        u32x2 o[4];
#pragma unroll
        for (int i = 0; i < 4; ++i) {
            const float y0 = v[i][0] * r * (1.f + sc[i][0]) + sh[i][0], y1 = v[i][1] * r * (1.f + sc[i][1]) + sh[i][1];
            const float y2 = v[i][2] * r * (1.f + sc[i][2]) + sh[i][2], y3 = v[i][3] * r * (1.f + sc[i][3]) + sh[i][3];
            o[i] = (u32x2){pack_bf16(y0, y1), pack_bf16(y2, y3)};
        }
#pragma unroll
        for (int i = 0; i < 4; ++i) *(u32x2*)(dst + (lane + 64 * i) * 4) = o[i];
    }
}
__device__ __forceinline__ void final_norm_phase(const Params& p) {
    const int lane = threadIdx.x & 63, w = threadIdx.x >> 6;
    for (int row = blockIdx.x * 4 + w; row < NLAT; row += gridDim.x * 4) {
        float* src = p.out + (size_t)row * DM;
        f32x4 v[4]; float ss = 0.f;
#pragma unroll
        for (int i = 0; i < 4; ++i) { v[i] = *(const f32x4*)(src + (lane + 64 * i) * 4); ss += v[i][0] * v[i][0] + v[i][1] * v[i][1] + v[i][2] * v[i][2] + v[i][3] * v[i][3]; }
        ss = wave_sum(ss);
        const float r = rsqrtf(ss * (1.0f / DM) + EPS);
        f32x4 wv[4];
#pragma unroll
        for (int i = 0; i < 4; ++i) wv[i] = *(const f32x4*)(p.final_norm_w + (lane + 64 * i) * 4);
#pragma unroll
        for (int i = 0; i < 4; ++i) v[i] = (f32x4){v[i][0] * r * wv[i][0], v[i][1] * r * wv[i][1], v[i][2] * r * wv[i][2], v[i][3] * r * wv[i][3]};
#pragma unroll
        for (int i = 0; i < 4; ++i) *(f32x4*)(src + (lane + 64 * i) * 4) = v[i];
    }
}

struct GemmDesc { const bf16_t* A; int lda; const bf16_t* Bt; int K; int Ks; int klen; };
constexpr int LDT = 72;

template <int MI, bool RS, class Epi>
__device__ __forceinline__ void gemm_tile(const GemmDesc& g, int tm, int tn, const Epi& epi, char* smem) {
    constexpr int BM = MI * 64;
    constexpr int NA = MI * 2;
    bf16_t* As = (bf16_t*)smem;
    bf16_t* Bs = As + BM * LDT;
    float* rsc = (float*)(smem + (BM + 128) * LDT * 2);
    const int t = threadIdx.x, lane = t & 63, w = __builtin_amdgcn_readfirstlane(t >> 6), wm = w >> 1, wn = w & 1;
    const int l31 = lane & 31, lh = lane >> 5;
    f32x16 acc[MI][2];
#pragma unroll
    for (int mi = 0; mi < MI; ++mi)
#pragma unroll
        for (int ni = 0; ni < 2; ++ni)
#pragma unroll
            for (int r = 0; r < 16; ++r) acc[mi][ni][r] = 0.f;
    const int lrow = t >> 3, lkc = (t & 7) * 8;
    const bf16_t* Ag = g.A + (size_t)(tm * BM + lrow) * g.lda + lkc;
    const bf16_t* Bg = g.Bt + (size_t)(tn * 128 + lrow) * g.K + lkc;
    u32x4 ra[NA], rb[4];
    float ss[NA];
#pragma unroll
    for (int i = 0; i < NA; ++i) ss[i] = 0.f;
#pragma unroll
    for (int i = 0; i < NA; ++i) ra[i] = *(const u32x4*)(Ag + (size_t)(32 * i) * g.lda);
#pragma unroll
    for (int i = 0; i < 4; ++i) rb[i] = *(const u32x4*)(Bg + (size_t)(32 * i) * g.K);
    const int nk = (g.klen ? g.klen : g.K) / 64;
    for (int kt = 0; kt < nk; ++kt) {
        if (kt) __syncthreads();
#pragma unroll
        for (int i = 0; i < NA; ++i) *(u32x4*)(As + (lrow + 32 * i) * LDT + lkc) = ra[i];
#pragma unroll
        for (int i = 0; i < 4; ++i) *(u32x4*)(Bs + (lrow + 32 * i) * LDT + lkc) = rb[i];
        if (RS) {
            if (kt * 64 < g.Ks) {
#pragma unroll
                for (int i = 0; i < NA; ++i)
#pragma unroll
                    for (int e = 0; e < 4; ++e) { const float a = bf_lo(ra[i][e]), b = bf_hi(ra[i][e]); ss[i] += a * a + b * b; }
            }
            if ((kt + 1) * 64 == g.Ks) {
#pragma unroll
                for (int i = 0; i < NA; ++i) {
                    float s = ss[i];
                    s += __shfl_xor(s, 1); s += __shfl_xor(s, 2); s += __shfl_xor(s, 4);
                    if ((t & 7) == 0) rsc[lrow + 32 * i] = rsqrtf(s / (float)g.Ks + EPS);
                }
            }
        }
        __syncthreads();
        if (kt + 1 < nk) {
            const int k0 = (kt + 1) * 64;
#pragma unroll
            for (int i = 0; i < NA; ++i) ra[i] = *(const u32x4*)(Ag + (size_t)(32 * i) * g.lda + k0);
#pragma unroll
            for (int i = 0; i < 4; ++i) rb[i] = *(const u32x4*)(Bg + (size_t)(32 * i) * g.K + k0);
        }
#pragma unroll
        for (int kk = 0; kk < 4; ++kk) {
            bf16x8 af[MI], bfr[2];
#pragma unroll
            for (int mi = 0; mi < MI; ++mi) af[mi] = *(const bf16x8*)(As + (wm * (MI * 32) + mi * 32 + l31) * LDT + kk * 16 + lh * 8);
#pragma unroll
            for (int ni = 0; ni < 2; ++ni) bfr[ni] = *(const bf16x8*)(Bs + (wn * 64 + ni * 32 + l31) * LDT + kk * 16 + lh * 8);
#pragma unroll
            for (int mi = 0; mi < MI; ++mi)
#pragma unroll
                for (int ni = 0; ni < 2; ++ni) acc[mi][ni] = mfma32(af[mi], bfr[ni], acc[mi][ni]);
        }
        if (RS) {
            if ((kt + 1) * 64 == g.Ks) {
#pragma unroll
                for (int mi = 0; mi < MI; ++mi) {
#pragma unroll
                    for (int g4 = 0; g4 < 4; ++g4) {
                        const f32x4 sv = *(const f32x4*)(rsc + wm * (MI * 32) + mi * 32 + 8 * g4 + 4 * lh);
#pragma unroll
                        for (int e = 0; e < 4; ++e) { acc[mi][0][4 * g4 + e] *= sv[e]; acc[mi][1][4 * g4 + e] *= sv[e]; }
                    }
                    asm volatile("" ::: "memory");
                }
            }
        }
    }
    if (Epi::USES_LDS) __syncthreads();
    epi.template operator()<MI, 0>(acc, tm * BM + wm * (MI * 32), tn * 128 + wn * 64, tn, wn, l31, lh, smem, w);
    if (MI == 4) epi.template operator()<MI, MI - 2>(acc, tm * BM + wm * (MI * 32) + 64, tn * 128 + wn * 64, tn, wn, l31, lh, smem, w);
    __syncthreads();
}


__device__ __forceinline__ u32x4 swap_pair16(u32x2 a  , u32x2 b  ) {
    const auto r0 = __builtin_amdgcn_permlane32_swap(a[0], b[0], false, false);
    const auto r1 = __builtin_amdgcn_permlane32_swap(a[1], b[1], false, false);
    return (u32x4){r0[0], r1[0], r0[1], r1[1]};
}
__device__ __forceinline__ void unswap_pair16(u32x4 wv, u32x2& a, u32x2& b) {
    const auto r0 = __builtin_amdgcn_permlane32_swap(wv[0], wv[2], false, false);
    const auto r1 = __builtin_amdgcn_permlane32_swap(wv[1], wv[3], false, false);
    a = (u32x2){r0[0], r1[0]}; b = (u32x2){r0[1], r1[1]};
}
constexpr int SLD = 68;
__device__ __forceinline__ void stage_store64(float* stg, const f32x16& a0, const f32x16& a1, bf16_t* dst, size_t ld, int l31, int lh) {
#pragma unroll
    for (int r = 0; r < 16; ++r) { stg[crow(r, lh) * SLD + l31] = a0[r]; stg[crow(r, lh) * SLD + 32 + l31] = a1[r]; }
    asm volatile("s_waitcnt lgkmcnt(0)" ::: "memory");
    const int lane = l31 + 32 * lh, rr = lane >> 3, c8 = (lane & 7) * 8;
#pragma unroll
    for (int i = 0; i < 4; ++i) {
        const f32x4 x = *(const f32x4*)(stg + (rr + 8 * i) * SLD + c8), y = *(const f32x4*)(stg + (rr + 8 * i) * SLD + c8 + 4);
        *(u32x4*)(dst + (size_t)(rr + 8 * i) * ld + c8) = (u32x4){pack_bf16(x[0], x[1]), pack_bf16(x[2], x[3]), pack_bf16(y[0], y[1]), pack_bf16(y[2], y[3])};
    }
    asm volatile("s_waitcnt lgkmcnt(0)" ::: "memory");
}
__device__ __forceinline__ void stage_store32(float* stg, const f32x16& a0, bf16_t* dst, size_t ld, int l31, int lh) {
#pragma unroll
    for (int r = 0; r < 16; ++r) stg[crow(r, lh) * SLD + l31] = a0[r];
    asm volatile("s_waitcnt lgkmcnt(0)" ::: "memory");
    const int lane = l31 + 32 * lh, rr = lane >> 2, c8 = (lane & 3) * 8;
#pragma unroll
    for (int i = 0; i < 2; ++i) {
        const f32x4 x = *(const f32x4*)(stg + (rr + 16 * i) * SLD + c8), y = *(const f32x4*)(stg + (rr + 16 * i) * SLD + c8 + 4);
        *(u32x4*)(dst + (size_t)(rr + 16 * i) * ld + c8) = (u32x4){pack_bf16(x[0], x[1]), pack_bf16(x[2], x[3]), pack_bf16(y[0], y[1]), pack_bf16(y[2], y[3])};
    }
    asm volatile("s_waitcnt lgkmcnt(0)" ::: "memory");
}
struct EpiProj0 {
    static constexpr bool USES_LDS = true;
    bf16_t* proj; float* dt_raw; const float* rope;
    template <int MI, int MO> __device__ __forceinline__ void operator()(const f32x16 (&acc)[MI][2], int mbase, int nbase, int tn, int wn, int l31, int lh, char* smem, int w) const {
        float* stg = (float*)smem + w * (32 * SLD);
        if (nbase >= P0W) {
            if (nbase == P0W && l31 < 16) {
#pragma unroll
                for (int mi = 0; mi < 2; ++mi)
#pragma unroll
                    for (int r = 0; r < 16; ++r) dt_raw[(size_t)(mbase + mi * 32 + crow(r, lh)) * 16 + l31] = acc[MO + mi][0][r];
            }
            return;
        }
        if (nbase < 1024) {
            const float sc = nbase >= 512 ? 0.125f : 1.0f;
            const bool lat = mbase >= NCTX;
#pragma unroll
            for (int mi = 0; mi < 2; ++mi) {
                f32x16 y1, y2;
#pragma unroll
                for (int r = 0; r < 16; ++r) {
                    const int row = mbase + mi * 32 + crow(r, lh);
                    float x1 = acc[MO + mi][0][r] * sc, x2 = acc[MO + mi][1][r] * sc;
                    if (lat) {
                        const int pp = (row - NCTX) & (SEQL - 1);
                        const int pos = l31 < 16 ? (pp >> 6) : (pp & 63);
                        const float c = rope[pos * 16 + (l31 & 15)], sn = rope[1024 + pos * 16 + (l31 & 15)];
                        const float t1 = x1 * c - x2 * sn, t2 = x1 * sn + x2 * c; x1 = t1; x2 = t2;
                    }
                    y1[r] = x1; y2[r] = x2;
                }
                stage_store64(stg, y1, y2, proj + (size_t)(mbase + mi * 32) * P0W + nbase, P0W, l31, lh);
            }
            return;
        }
#pragma unroll
        for (int mi = 0; mi < 2; ++mi) stage_store64(stg, acc[MO + mi][0], acc[MO + mi][1], proj + (size_t)(mbase + mi * 32) * P0W + nbase, P0W, l31, lh);
    }
};
struct EpiResid {
    static constexpr bool USES_LDS = true;
    const float* hin_ctx; const float* hin_lat; float* hout_ctx; float* hout_lat; const float* gate_base  ; int row_off;
    template <int MI, int MO> __device__ __forceinline__ void operator()(const f32x16 (&acc)[MI][2], int mbase, int nbase, int tn, int wn, int l31, int lh, char* smem, int w) const {
        const int grow0 = mbase + row_off;
        const float* gp = gate_base + (size_t)cond_of_row(grow0) * 6144;
        const float* hin; float* hout;
        if (grow0 < NCTX) { hin = hin_ctx + (size_t)grow0 * DM; hout = hout_ctx + (size_t)grow0 * DM; }
        else { hin = hin_lat + (size_t)(grow0 - NCTX) * DM; hout = hout_lat + (size_t)(grow0 - NCTX) * DM; }
        float* stg = (float*)smem + w * (32 * SLD);
        const int lane = l31 + 32 * lh;
        const int rr = lane >> 4, c4 = (lane & 15) * 4;
        const f32x4 gt4 = *(const f32x4*)(gp + nbase + c4);
        const int goff = rr * DM + nbase + c4;
#pragma unroll
        for (int mi = 0; mi < 2; ++mi) {
#pragma unroll
            for (int ni = 0; ni < 2; ++ni)
#pragma unroll
                for (int r = 0; r < 16; ++r) stg[crow(r, lh) * SLD + ni * 32 + l31] = acc[MO + mi][ni][r];
            asm volatile("s_waitcnt lgkmcnt(0)" ::: "memory");
#pragma unroll
            for (int i = 0; i < 8; ++i) {
                const f32x4 a = *(const f32x4*)(stg + (rr + 4 * i) * SLD + c4);
                const size_t ro = (size_t)(mi * 32 + 4 * i) * DM;
                const f32x4 hv = *(const f32x4*)(hin + ro + goff);
                *(f32x4*)(hout + ro + goff) = (f32x4){hv[0] + gt4[0] * a[0], hv[1] + gt4[1] * a[1], hv[2] + gt4[2] * a[2], hv[3] + gt4[3] * a[3]};
            }
            asm volatile("s_waitcnt lgkmcnt(0)" ::: "memory");
        }
    }
};
struct EpiResidAtomic {
    static constexpr bool USES_LDS = false;
    float* hout_ctx; const float* gate_base;
    template <int MI, int MO> __device__ __forceinline__ void operator()(const f32x16 (&acc)[MI][2], int mbase, int nbase, int tn, int wn, int l31, int lh, char* smem, int w) const {
        const float* gp = gate_base + (size_t)cond_of_row(mbase) * 6144;
        float* hout = hout_ctx + (size_t)mbase * DM;
        const int loff = 4 * lh * DM + nbase + l31;
#pragma unroll
        for (int ni = 0; ni < 2; ++ni) {
            const float gt = gp[nbase + ni * 32 + l31];
#pragma unroll
            for (int mi = 0; mi < 2; ++mi) {
#pragma unroll
                for (int r = 0; r < 16; ++r) {
                    const size_t ro = (size_t)(mi * 32 + (r & 3) + 8 * (r >> 2)) * DM + ni * 32;
                    unsafeAtomicAdd(hout + ro + loff, gt * acc[MO + mi][ni][r]);
                }
            }
        }
    }
};
struct EpiSwiglu {
    static constexpr bool USES_LDS = true;
    bf16_t* hmid;
    template <int MI, int MO> __device__ __forceinline__ void operator()(const f32x16 (&acc)[MI][2], int mbase, int nbase, int tn, int wn, int l31, int lh, char* smem, int w) const {
        float* stg = (float*)smem + w * (32 * SLD);
#pragma unroll
        for (int mi = 0; mi < 2; ++mi) {
            f32x16 hv;
#pragma unroll
            for (int r = 0; r < 16; ++r) hv[r] = silu_f(acc[MO + mi][0][r]) * acc[MO + mi][1][r];
            stage_store32(stg, hv, hmid + (size_t)(mbase + mi * 32) * DFF + tn * 64 + wn * 32, DFF, l31, lh);
        }
    }
};
struct EpiCqkv {
    static constexpr bool USES_LDS = true;
    bf16_t* cqkv; bf16_t* kpe; const float* rope;
    template <int MI, int MO> __device__ __forceinline__ void operator()(const f32x16 (&acc)[MI][2], int mbase, int nbase, int tn, int wn, int l31, int lh, char* smem, int w) const {
#pragma unroll
        for (int ni = 0; ni < 2; ++ni) {
            const int c0 = nbase + ni * 32;
            if (c0 >= CQW) continue;
            if (c0 == 1024) {
                const bool lat = mbase >= NCTX;
#pragma unroll
                for (int mi = 0; mi < 2; ++mi)
#pragma unroll
                    for (int r = 0; r < 16; ++r) {
                        const int row = mbase + mi * 32 + crow(r, lh);
                        float v = acc[MO + mi][ni][r];
                        if (lat) {
                            const float o = __shfl_xor(v, 16);
                            const int pp = (row - NCTX) & (SEQL - 1);
                            const int i = l31 & 15;
                            const int pos = i < 8 ? (pp >> 6) : (pp & 63);
                            const float c = rope[pos * 8 + (i & 7)], s = rope[512 + pos * 8 + (i & 7)];
                            v = (l31 < 16) ? (v * c - o * s) : (o * s + v * c);
                        }
                        kpe[(size_t)row * 32 + l31] = f2bf(v);
                    }
            } else {
                float* stg = (float*)smem + w * (32 * SLD);
#pragma unroll
                for (int mi = 0; mi < 2; ++mi) stage_store32(stg, acc[MO + mi][ni], cqkv + (size_t)(mbase + mi * 32) * CQW + c0, CQW, l31, lh);
            }
        }
    }
};
struct EpiQ {
    static constexpr bool USES_LDS = true;
    bf16_t* q; const float* rope;
    template <int MI, int MO> __device__ __forceinline__ void operator()(const f32x16 (&acc)[MI][2], int mbase, int nbase, int tn, int wn, int l31, int lh, char* smem, int w) const {
        const float qs = 0.10206207261596575f * 1.4426950408889634f;
        float* stg = (float*)smem + w * (32 * SLD);
#pragma unroll
        for (int ni = 0; ni < 2; ++ni) {
            const int c0 = nbase + ni * 32;
            const bool is_rope = ((c0 >> 5) % 3) == 2;
#pragma unroll
            for (int mi = 0; mi < 2; ++mi) {
                f32x16 y;
#pragma unroll
                for (int r = 0; r < 16; ++r) {
                    const int row = mbase + mi * 32 + crow(r, lh);
                    float v = acc[MO + mi][ni][r] * qs;
                    if (is_rope) {
                        const float o = __shfl_xor(v, 16);
                        const int pp = row & (SEQL - 1);
                        const int i = l31 & 15;
                        const int pos = i < 8 ? (pp >> 6) : (pp & 63);
                        const float c = rope[pos * 8 + (i & 7)], sn = rope[512 + pos * 8 + (i & 7)];
                        v = (l31 < 16) ? (v * c - o * sn) : (o * sn + v * c);
                    }
                    y[r] = v;
                }
                stage_store32(stg, y, q + (size_t)(mbase + mi * 32) * 1536 + c0, 1536, l31, lh);
            }
        }
    }
};
struct EpiKV {
    static constexpr bool USES_LDS = true;
    bf16_t* knope; bf16_t* vt;
    template <int MI, int MO> __device__ __forceinline__ void operator()(const f32x16 (&acc)[MI][2], int mbase, int nbase, int tn, int wn, int l31, int lh, char* smem, int w) const {
        const int head = tn;
        if (wn == 0) {
            float* stg = (float*)smem + w * (32 * SLD);
#pragma unroll
            for (int mi = 0; mi < 2; ++mi) stage_store64(stg, acc[MO + mi][0], acc[MO + mi][1], knope + (size_t)(mbase + mi * 32) * 1024 + head * 64, 1024, l31, lh);
        } else {
            int b, key0;
            if (mbase < NCTX) { b = mbase >> 8; key0 = mbase & 255; } else { b = (mbase - NCTX) >> 12; key0 = CTXL + ((mbase - NCTX) & (SEQL - 1)); }
#pragma unroll
            for (int mi = 0; mi < 2; ++mi)
#pragma unroll
                for (int ni = 0; ni < 2; ++ni) {
                    bf16_t* vp = vt + ((size_t)(b * 16 + head) * 64 + ni * 32 + l31) * NKEY + key0 + mi * 32 + 8 * lh;
#pragma unroll
                    for (int g2 = 0; g2 < 2; ++g2) {
                        const int ga = 2 * g2, gb = 2 * g2 + 1;
                        const u32x2 a = {pack_bf16(acc[MO + mi][ni][4 * ga], acc[MO + mi][ni][4 * ga + 1]), pack_bf16(acc[MO + mi][ni][4 * ga + 2], acc[MO + mi][ni][4 * ga + 3])};
                        const u32x2 bq = {pack_bf16(acc[MO + mi][ni][4 * gb], acc[MO + mi][ni][4 * gb + 1]), pack_bf16(acc[MO + mi][ni][4 * gb + 2], acc[MO + mi][ni][4 * gb + 3])};
                        *(u32x4*)(vp + 16 * g2) = swap_pair16(a, bq);
                    }
                }
        }
    }
};


struct TileOrder {
    int total, per, x, j, nt, mt;
    __device__ __forceinline__ void init(int mt_, int nt_) { mt = mt_; nt = nt_; total = mt_ * nt_; per = (total + 7) >> 3; x = blockIdx.x & 7; j = blockIdx.x >> 3; }
    __device__ __forceinline__ bool get(int k, int& tm, int& tn) const { return at(k * (int)(gridDim.x >> 3) + j, tm, tn); }
    __device__ __forceinline__ bool at(int li, int& tm, int& tn) const {
        if (li >= per) return false;
        const int lin = x * per + li;
        if (lin >= total) return false;
        constexpr int GM = 4;
        const int gsz = GM * nt, gid = lin / gsz, within = lin - gid * gsz;
        const int rem = mt - gid * GM, gm = rem < GM ? rem : GM;
        tm = gid * GM + within % gm; tn = within / gm;
        return true;
    }
};
template <int MI, bool RS, class Epi>
__device__ __forceinline__ void gemm_phase(const GemmDesc& g, int mt, int nt, const Epi& epi, char* smem) {
    TileOrder ord; ord.init(mt, nt);
    int tm, tn;
    for (int k = 0; ord.get(k, tm, tn); ++k) gemm_tile<MI, RS>(g, tm, tn, epi, smem);
}
template <class Epi>
__device__ __forceinline__ void gemm_phase_tail2(const GemmDesc& g, int mt, int nt, const Epi& epi, char* smem) {
    TileOrder ord; ord.init(mt, nt);
    const int slots = gridDim.x >> 3;
    const int R = ord.per / slots, tailn = ord.per - R * slots;
    const bool split = tailn > 0 && 2 * tailn <= slots;
    int tm, tn;
    for (int k = 0; k < (split ? R : R + 1); ++k) { if (ord.get(k, tm, tn)) gemm_tile<4, false>(g, tm, tn, epi, smem); }
    if (split && ord.j < 2 * tailn) {
        const int lin = ord.x * ord.per + R * slots + (ord.j >> 1);
        if (lin < ord.total) {
            constexpr int GM = 4;
            const int gsz = GM * nt, gid = lin / gsz, within = lin - gid * gsz;
            const int rem = mt - gid * GM, gm = rem < GM ? rem : GM;
            tm = gid * GM + within % gm; tn = within / gm;
            gemm_tile<2, false>(g, tm * 2 + (ord.j & 1), tn, epi, smem);
        }
    }
}

__device__ __forceinline__ void conv_phase(const Params& p) {
    const bf16_t* proj = p.big;
    bf16_t* xact = p.abuf;
    const long total = (long)NTOK * 128;
    for (long idx = (long)blockIdx.x * 256 + threadIdx.x; idx < total; idx += (long)gridDim.x * 256) {
        const int row = (int)(idx >> 7), c8 = ((int)idx & 127) * 8;
        int tpos, len;
        if (row < NCTX) { tpos = row & (CTXL - 1); len = CTXL; } else { tpos = (row - NCTX) & (SEQL - 1); len = SEQL; }
        float a[8];
        { const f32x4 b0 = *(const f32x4*)(p.conv_b + c8), b1 = *(const f32x4*)(p.conv_b + c8 + 4);
          a[0] = b0[0]; a[1] = b0[1]; a[2] = b0[2]; a[3] = b0[3]; a[4] = b1[0]; a[5] = b1[1]; a[6] = b1[2]; a[7] = b1[3]; }
#pragma unroll
        for (int j = 0; j < 5; ++j) {
            const int tt = tpos + j - 2;
            if (tt < 0 || tt >= len) continue;
            const u32x4 xv = *(const u32x4*)(proj + (size_t)(row + j - 2) * P0W + 2560 + c8);
            const f32x4 w0 = *(const f32x4*)(p.conv_w + j * 1024 + c8), w1 = *(const f32x4*)(p.conv_w + j * 1024 + c8 + 4);
            a[0] += w0[0] * bf_lo(xv[0]); a[1] += w0[1] * bf_hi(xv[0]); a[2] += w0[2] * bf_lo(xv[1]); a[3] += w0[3] * bf_hi(xv[1]);
            a[4] += w1[0] * bf_lo(xv[2]); a[5] += w1[1] * bf_hi(xv[2]); a[6] += w1[2] * bf_lo(xv[3]); a[7] += w1[3] * bf_hi(xv[3]);
        }
#pragma unroll
        for (int e = 0; e < 8; ++e) a[e] = silu_f(a[e]);
        *(u32x4*)(xact + (size_t)row * 1024 + c8) = (u32x4){pack_bf16(a[0], a[1]), pack_bf16(a[2], a[3]), pack_bf16(a[4], a[5]), pack_bf16(a[6], a[7])};
    }
    const int total2 = NTOK * 16;
    for (int idx = blockIdx.x * 256 + threadIdx.x; idx < total2; idx += gridDim.x * 256) {
        const int dh = idx & 15;
        const float xr = p.dt_raw[idx] + p.dt_bias[dh];
        const float dt = xr > 20.f ? xr : log1pf(__expf(xr));
        p.dtv[idx] = dt;
        p.la[idx] = -dt * __expf(p.a_log[dh]);
    }
}

constexpr int LDV = 136;
struct ScanItem { int b, n, hh, h, rowb; bool isret; };
__device__ __forceinline__ ScanItem scan_item(int item) {
    ScanItem s; s.hh = item / (NBATCH * NCHUNK); const int bn = item % (NBATCH * NCHUNK); s.n = bn % NCHUNK; s.b = bn / NCHUNK;
    s.isret = s.hh < 8; s.h = s.hh & 7;
    s.rowb = s.n < 2 ? s.b * CTXL + s.n * 128 : NCTX + s.b * SEQL + (s.n - 2) * 128;
    return s;
}
__device__ __forceinline__ float log_sigmoid_f(float x) { return fminf(x, 0.f) - log1pf(__expf(-fabsf(x))); }
__device__ __forceinline__ void scan_cums(const Params& p, const ScanItem& s, float* cumf, float* cumb, float* vsf, float* vsb, float* xch) {
    const int t = threadIdx.x, lane = t & 63, w = t >> 6;
    const int dir = t >> 7, tt = t & 127;
    const int j = dir == 0 ? tt : 127 - tt;
    float la, vs;
    if (s.isret) { la = log_sigmoid_f(p.decay_logit[dir * 8 + s.h]); vs = 1.0f; }
    else { la = p.la[(size_t)(s.rowb + j) * 16 + dir * 8 + s.h]; vs = p.dtv[(size_t)(s.rowb + j) * 16 + dir * 8 + s.h]; }
    float v = la;
#pragma unroll
    for (int o = 1; o < 64; o <<= 1) { const float u = __shfl_up(v, o); if (lane >= o) v += u; }
    if (lane == 63) xch[w] = v;
    __syncthreads();
    if (w & 1) v += xch[w - 1];
    if (dir == 0) { cumf[j] = v; vsf[j] = vs; } else { cumb[j] = v; vsb[j] = vs; }
    __syncthreads();
}

__device__ __forceinline__ void scan_state_phase(const Params& p, char* smem) {
    bf16_t* Vtf = (bf16_t*)smem;
    bf16_t* Vtb = Vtf + 64 * LDV;
    bf16_t* Kt = Vtb + 64 * LDV;
    float* cumf = (float*)(Kt + 64 * LDV);
    float* cumb = cumf + 128; float* vsf = cumb + 128; float* vsb = vsf + 128; float* wf = vsb + 128; float* wb = wf + 128; float* xch = wb + 128;
    const int t = threadIdx.x, lane = t & 63, w = t >> 6, l31 = lane & 31, lh = lane >> 5;
    for (int item = blockIdx.x; item < NITEM; item += gridDim.x) {
        const ScanItem s = scan_item(item);
        scan_cums(p, s, cumf, cumb, vsf, vsb, xch);
        if (t < 128) wf[t] = __expf(cumf[127] - cumf[t]) * vsf[t]; else wb[t - 128] = __expf(cumb[0] - cumb[t - 128]) * vsb[t - 128];
        if (t == 0) { p.tot[item * 2 + 0] = __expf(cumf[127]); p.tot[item * 2 + 1] = __expf(cumb[0]); }
        __syncthreads();
        const bf16_t* vsrc; int ldv_; const bf16_t* ksrc; int ldk_; int dk;
        if (s.isret) { vsrc = p.big + (size_t)s.rowb * P0W + 1024 + s.h * 64; ldv_ = P0W; ksrc = p.big + (size_t)s.rowb * P0W + 512 + s.h * 64; ldk_ = P0W; dk = 64; }
        else { vsrc = p.abuf + (size_t)s.rowb * 1024 + s.h * 64; ldv_ = 1024; ksrc = p.abuf + (size_t)s.rowb * 1024 + 512 + (s.h >> 2) * 128; ldk_ = 1024; dk = 128; }
#pragma unroll
        for (int i = 0; i < 4; ++i) {
            const int cidx = t + 256 * i, j = cidx >> 3, vc = (cidx & 7) * 8;
            const u32x4 xv = *(const u32x4*)(vsrc + (size_t)j * ldv_ + vc);
            const float f = wf[j], bb = wb[j];
#pragma unroll
            for (int e = 0; e < 4; ++e) {
                const float lo = bf_lo(xv[e]), hi = bf_hi(xv[e]);
                Vtf[(vc + 2 * e) * LDV + j] = f2bf(lo * f); Vtf[(vc + 2 * e + 1) * LDV + j] = f2bf(hi * f);
                Vtb[(vc + 2 * e) * LDV + j] = f2bf(lo * bb); Vtb[(vc + 2 * e + 1) * LDV + j] = f2bf(hi * bb);
            }
        }
        bf16_t* stbase = s.isret ? p.st_ret + ((size_t)((s.b * NCHUNK + s.n) * 8 + s.h) * 2) * 4096
                                 : p.st_ssd + ((size_t)((s.b * NCHUNK + s.n) * 8 + s.h) * 2) * 8192;
        for (int dh = 0; dh < dk / 64; ++dh) {
#pragma unroll
            for (int i = 0; i < 4; ++i) {
                const int cidx = t + 256 * i, j = cidx >> 3, dc = (cidx & 7) * 8;
                const u32x4 xv = *(const u32x4*)(ksrc + (size_t)j * ldk_ + dh * 64 + dc);
#pragma unroll
                for (int e = 0; e < 4; ++e) { Kt[(dc + 2 * e) * LDV + j] = (bf16_t)(xv[e] & 0xffffu); Kt[(dc + 2 * e + 1) * LDV + j] = (bf16_t)(xv[e] >> 16); }
            }
            __syncthreads();
            const int dir = w >> 1, vt = w & 1;
            const bf16_t* Vw = dir ? Vtb : Vtf;
            bf16_t* st = stbase + (size_t)dir * 64 * dk;
#pragma unroll
            for (int dt = 0; dt < 2; ++dt) {
                f32x16 acc;
#pragma unroll
                for (int r = 0; r < 16; ++r) acc[r] = 0.f;
#pragma unroll
                for (int st8 = 0; st8 < 8; ++st8) {
                    const bf16x8 a = *(const bf16x8*)(Kt + (dt * 32 + l31) * LDV + st8 * 16 + lh * 8);
                    const bf16x8 bq = *(const bf16x8*)(Vw + (vt * 32 + l31) * LDV + st8 * 16 + lh * 8);
                    acc = mfma32(a, bq, acc);
                }
#pragma unroll
                for (int g2 = 0; g2 < 2; ++g2) {
                    const int ga = 2 * g2, gb = 2 * g2 + 1;
                    const u32x2 a = {pack_bf16(acc[4 * ga], acc[4 * ga + 1]), pack_bf16(acc[4 * ga + 2], acc[4 * ga + 3])};
                    const u32x2 bq = {pack_bf16(acc[4 * gb], acc[4 * gb + 1]), pack_bf16(acc[4 * gb + 2], acc[4 * gb + 3])};
                    *(u32x4*)(st + (size_t)(vt * 32 + l31) * dk + dh * 64 + dt * 32 + 16 * g2 + 8 * lh) = swap_pair16(a, bq);
                }
            }
            __syncthreads();
        }
    }
}

__device__ __forceinline__ void scan_pass_phase(const Params& p) {
    const int total = NBATCH * 2 * 12288;
    for (int gid = blockIdx.x * 256 + threadIdx.x; gid < total; gid += gridDim.x * 256) {
        const int bd = gid / 12288, e = gid % 12288;
        const int b = bd >> 1, dir = bd & 1;
        bf16_t* base; int E, h, e8, hh;
        if (e < 4096) { h = e >> 9; e8 = (e & 511) * 8; E = 4096; base = p.st_ret; hh = h; }
        else { const int e2 = e - 4096; h = e2 >> 10; e8 = (e2 & 1023) * 8; E = 8192; base = p.st_ssd; hh = 8 + h; }
        float S[8];
#pragma unroll
        for (int i = 0; i < 8; ++i) S[i] = 0.f;
        for (int step = 0; step < NCHUNK; ++step) {
            const int n = dir == 0 ? step : (step == 0 ? 1 : (step == 1 ? 0 : 35 - step));
            bf16_t* ptr = base + ((size_t)((b * NCHUNK + n) * 8 + h) * 2 + dir) * E + e8;
            const u32x4 kv = *(const u32x4*)ptr;
            const float tt = p.tot[(hh * (NBATCH * NCHUNK) + b * NCHUNK + n) * 2 + dir];
            *(u32x4*)ptr = (u32x4){pack_bf16(S[0], S[1]), pack_bf16(S[2], S[3]), pack_bf16(S[4], S[5]), pack_bf16(S[6], S[7])};
#pragma unroll
            for (int i = 0; i < 4; ++i) { S[2 * i] = tt * S[2 * i] + bf_lo(kv[i]); S[2 * i + 1] = tt * S[2 * i + 1] + bf_hi(kv[i]); }
        }
    }
}

template <int DK>
__device__ __forceinline__ void scan_out_item(const Params& p, const ScanItem& s, bf16_t* Vt, const float* cumf, const float* cumb, const float* vsf, const float* vsb) {
    const int t = threadIdx.x, lane = t & 63, w = t >> 6, l31 = lane & 31, lh = lane >> 5;
    constexpr int NS = DK / 16;
    const bf16_t* qsrc; const bf16_t* ksrc; int ld;
    if (DK == 64) { qsrc = p.big + (size_t)s.rowb * P0W + s.h * 64; ksrc = qsrc + 512; ld = P0W; }
    else { ksrc = p.abuf + (size_t)s.rowb * 1024 + 512 + (s.h >> 2) * 128; qsrc = ksrc + 256; ld = 1024; }
    const int iq = w * 32 + l31;
    bf16x8 qf[NS];
#pragma unroll
    for (int st = 0; st < NS; ++st) qf[st] = *(const bf16x8*)(qsrc + (size_t)iq * ld + st * 16 + lh * 8);
    f32x16 O[2];
#pragma unroll
    for (int r = 0; r < 16; ++r) { O[0][r] = 0.f; O[1][r] = 0.f; }
    const float cif = cumf[iq], cib = cumb[iq];
#pragma unroll 1
    for (int kt = 0; kt < 4; ++kt) {
        f32x16 sT;
#pragma unroll
        for (int r = 0; r < 16; ++r) sT[r] = 0.f;
#pragma unroll
        for (int st = 0; st < NS; ++st) {
            const bf16x8 kf = *(const bf16x8*)(ksrc + (size_t)(kt * 32 + l31) * ld + st * 16 + lh * 8);
            sT = mfma32(kf, qf[st], sT);
        }
        const int wu = __builtin_amdgcn_readfirstlane(w);
        if (kt < wu) {
#pragma unroll
            for (int r = 0; r < 16; ++r) { const int j = kt * 32 + crow(r, lh); sT[r] *= __expf(cif - cumf[j]) * vsf[j]; }
        } else if (kt > wu) {
#pragma unroll
            for (int r = 0; r < 16; ++r) { const int j = kt * 32 + crow(r, lh); sT[r] *= __expf(cib - cumb[j]) * vsb[j]; }
        } else {
#pragma unroll
            for (int r = 0; r < 16; ++r) {
                const int j = kt * 32 + crow(r, lh);
                const float dec = (j <= iq) ? __expf(cif - cumf[j]) * vsf[j] : __expf(cib - cumb[j]) * vsb[j];
                sT[r] *= dec;
            }
        }
#pragma unroll
        for (int ts = 0; ts < 2; ++ts) {
            const u32x4 pk = {pack_bf16(sT[8 * ts + 0], sT[8 * ts + 1]), pack_bf16(sT[8 * ts + 2], sT[8 * ts + 3]), pack_bf16(sT[8 * ts + 4], sT[8 * ts + 5]), pack_bf16(sT[8 * ts + 6], sT[8 * ts + 7])};
            const bf16x8 pb = as_bf16x8(pk);
#pragma unroll
            for (int vt = 0; vt < 2; ++vt) {
                const bf16_t* vp = Vt + (vt * 32 + l31) * LDV + kt * 32 + 16 * ts + 4 * lh;
                const u32x2 v0 = *(const u32x2*)vp, v1 = *(const u32x2*)(vp + 8);
                O[vt] = mfma32(as_bf16x8((u32x4){v0[0], v0[1], v1[0], v1[1]}), pb, O[vt]);
            }
        }
    }
    const bf16_t* stb = (DK == 64) ? p.st_ret + ((size_t)((s.b * NCHUNK + s.n) * 8 + s.h) * 2) * 4096
                                   : p.st_ssd + ((size_t)((s.b * NCHUNK + s.n) * 8 + s.h) * 2) * 8192;
#pragma unroll
    for (int dir = 0; dir < 2; ++dir) {
        const float ee = __expf(dir == 0 ? cif : cib);
#pragma unroll
        for (int vt = 0; vt < 2; ++vt) {
            f32x16 T;
#pragma unroll
            for (int r = 0; r < 16; ++r) T[r] = 0.f;
#pragma unroll
            for (int st = 0; st < NS; ++st) {
                const bf16x8 sa = *(const bf16x8*)(stb + (size_t)dir * 64 * DK + (size_t)(vt * 32 + l31) * DK + st * 16 + lh * 8);
                T = mfma32(sa, qf[st], T);
            }
#pragma unroll
            for (int r = 0; r < 16; ++r) O[vt][r] += ee * T[r];
        }
    }
    const int row = s.rowb + iq;
    if (DK == 64) {
        float sm = 0.f;
#pragma unroll
        for (int r = 0; r < 16; ++r) sm += O[0][r] + O[1][r];
        sm += __shfl_xor(sm, 32);
        const float mu = sm * (1.0f / 64.0f);
        float vr = 0.f;
#pragma unroll
        for (int r = 0; r < 16; ++r) { const float d0 = O[0][r] - mu, d1 = O[1][r] - mu; vr += d0 * d0 + d1 * d1; }
        vr += __shfl_xor(vr, 32);
        const float rstd = rsqrtf(vr * (1.0f / 64.0f) + EPS);
        bf16_t* gp = p.big + (size_t)row * P0W + 2048 + s.h * 64;
#pragma unroll
        for (int vt = 0; vt < 2; ++vt) {
            u32x2 gv[4]; f32x4 gw[4];
#pragma unroll
            for (int g2 = 0; g2 < 2; ++g2) unswap_pair16(*(const u32x4*)(gp + vt * 32 + 16 * g2 + 8 * lh), gv[2 * g2], gv[2 * g2 + 1]);
#pragma unroll
            for (int g4 = 0; g4 < 4; ++g4) gw[g4] = *(const f32x4*)(p.gn_w + s.h * 64 + vt * 32 + 8 * g4 + 4 * lh);
            u32x2 ov[4];
#pragma unroll
            for (int g4 = 0; g4 < 4; ++g4) {
                const float y0 = (O[vt][4 * g4 + 0] - mu) * rstd * gw[g4][0] * silu_f(bf_lo(gv[g4][0]));
                const float y1 = (O[vt][4 * g4 + 1] - mu) * rstd * gw[g4][1] * silu_f(bf_hi(gv[g4][0]));
                const float y2 = (O[vt][4 * g4 + 2] - mu) * rstd * gw[g4][2] * silu_f(bf_lo(gv[g4][1]));
                const float y3 = (O[vt][4 * g4 + 3] - mu) * rstd * gw[g4][3] * silu_f(bf_hi(gv[g4][1]));
                ov[g4] = (u32x2){pack_bf16(y0, y1), pack_bf16(y2, y3)};
            }
#pragma unroll
            for (int g2 = 0; g2 < 2; ++g2) *(u32x4*)(gp + vt * 32 + 16 * g2 + 8 * lh) = swap_pair16(ov[2 * g2], ov[2 * g2 + 1]);
        }
    } else {
        const float dsk = p.ssd_d[s.h];
        bf16_t* zp = p.big + (size_t)row * P0W + 1536 + s.h * 64;
        const bf16_t* xp = p.abuf + (size_t)row * 1024 + s.h * 64;
        u32x2 zv[2][4], xv[2][4];
#pragma unroll
        for (int vt = 0; vt < 2; ++vt)
#pragma unroll
            for (int g2 = 0; g2 < 2; ++g2) {
                unswap_pair16(*(const u32x4*)(zp + vt * 32 + 16 * g2 + 8 * lh), zv[vt][2 * g2], zv[vt][2 * g2 + 1]);
                unswap_pair16(*(const u32x4*)(xp + vt * 32 + 16 * g2 + 8 * lh), xv[vt][2 * g2], xv[vt][2 * g2 + 1]);
            }
        u32x2 ov[2][4];
#pragma unroll
        for (int vt = 0; vt < 2; ++vt)
#pragma unroll
            for (int g4 = 0; g4 < 4; ++g4) {
                const float y0 = (O[vt][4 * g4 + 0] + dsk * bf_lo(xv[vt][g4][0])) * silu_f(bf_lo(zv[vt][g4][0]));
                const float y1 = (O[vt][4 * g4 + 1] + dsk * bf_hi(xv[vt][g4][0])) * silu_f(bf_hi(zv[vt][g4][0]));
                const float y2 = (O[vt][4 * g4 + 2] + dsk * bf_lo(xv[vt][g4][1])) * silu_f(bf_lo(zv[vt][g4][1]));
                const float y3 = (O[vt][4 * g4 + 3] + dsk * bf_hi(xv[vt][g4][1])) * silu_f(bf_hi(zv[vt][g4][1]));
                ov[vt][g4] = (u32x2){pack_bf16(y0, y1), pack_bf16(y2, y3)};
            }
#pragma unroll
        for (int vt = 0; vt < 2; ++vt)
#pragma unroll
            for (int g2 = 0; g2 < 2; ++g2) *(u32x4*)(zp + vt * 32 + 16 * g2 + 8 * lh) = swap_pair16(ov[vt][2 * g2], ov[vt][2 * g2 + 1]);
    }
}

__device__ __forceinline__ void scan_out_phase(const Params& p, char* smem) {
    bf16_t* Vt = (bf16_t*)smem;
    float* cumf = (float*)(Vt + 64 * LDV);
    float* cumb = cumf + 128; float* vsf = cumb + 128; float* vsb = vsf + 128; float* xch = vsb + 128;
    const int t = threadIdx.x;
    for (int item = blockIdx.x; item < NITEM; item += gridDim.x) {
        const ScanItem s = scan_item(item);
        scan_cums(p, s, cumf, cumb, vsf, vsb, xch);
        const bf16_t* vsrc; int ldv_;
        if (s.isret) { vsrc = p.big + (size_t)s.rowb * P0W + 1024 + s.h * 64; ldv_ = P0W; }
        else { vsrc = p.abuf + (size_t)s.rowb * 1024 + s.h * 64; ldv_ = 1024; }
#pragma unroll
        for (int i = 0; i < 4; ++i) {
            const int cidx = t + 256 * i, j = cidx >> 3, vc = (cidx & 7) * 8;
            const u32x4 xv = *(const u32x4*)(vsrc + (size_t)j * ldv_ + vc);
#pragma unroll
            for (int e = 0; e < 4; ++e) { Vt[(vc + 2 * e) * LDV + j] = (bf16_t)(xv[e] & 0xffffu); Vt[(vc + 2 * e + 1) * LDV + j] = (bf16_t)(xv[e] >> 16); }
        }
        __syncthreads();
        if (s.isret) scan_out_item<64>(p, s, Vt, cumf, cumb, vsf, vsb);
        else scan_out_item<128>(p, s, Vt, cumf, cumb, vsf, vsb);
        __syncthreads();
    }
}

constexpr int LDK = 104, LDVT = 72, KT = 64;
__device__ __forceinline__ void attn_phase(const Params& p, const bf16_t* qbuf, const bf16_t* knope, const bf16_t* vtg, bf16_t* obuf, char* smem) {
    bf16_t* Lb = (bf16_t*)smem;
    constexpr int KVB = KT * LDK + 64 * LDVT;
    const int t = threadIdx.x, lane = t & 63, w = __builtin_amdgcn_readfirstlane(t >> 6), l31 = lane & 31, lh = lane >> 5;
    const int xj = blockIdx.x >> 3, ppr = (gridDim.x >> 3) >> 4;
    for (int k = 0; ppr > 0; ++k) {
        const int pi = (blockIdx.x & 7) + 8 * (k * ppr + (xj >> 4));
        if (pi >= NBATCH * 16 || (xj >> 4) >= ppr) break;
        const int qb = xj & 15, hd = pi & 15, b = pi >> 4;
        const int m0 = b * SEQL + qb * 256 + w * 64 + l31;
        bf16x8 qf[2][6];
#pragma unroll
        for (int qt = 0; qt < 2; ++qt)
#pragma unroll
            for (int st = 0; st < 6; ++st) qf[qt][st] = *(const bf16x8*)(qbuf + (size_t)(m0 + 32 * qt) * 1536 + hd * 96 + st * 16 + lh * 8);
        f32x16 O[2][2];
#pragma unroll
        for (int r = 0; r < 16; ++r) { O[0][0][r] = 0.f; O[0][1][r] = 0.f; O[1][0][r] = 0.f; O[1][1][r] = 0.f; }
        float mrun[2] = {-1e30f, -1e30f}, lsum[2] = {0.f, 0.f};
        u32x4 rk[3], rv[2];
        const bf16_t* vbase = vtg + (size_t)(b * 16 + hd) * 64 * NKEY;
        const int kn_off0 = (t >> 3) * 1024 + (t & 7) * 8, kn_off1 = kn_off0 + 32 * 1024;
        const int kp_off = (t >> 2) * 32 + (t & 3) * 8;
        const int v_off0 = (t >> 3) * NKEY + (t & 7) * 8, v_off1 = v_off0 + 32 * NKEY;
        const int kn_lds0 = (t >> 3) * LDK + (t & 7) * 8, kn_lds1 = kn_lds0 + 32 * LDK, kp_lds = (t >> 2) * LDK + 64 + (t & 3) * 8;
        const int v_lds0 = (t >> 3) * LDVT + (t & 7) * 8, v_lds1 = v_lds0 + 32 * LDVT;
        auto gload = [&](int tile) {
            const int k0 = tile * KT;
            const int rowk0 = k0 < CTXL ? b * CTXL + k0 : NCTX + b * SEQL + (k0 - CTXL);
            const bf16_t* knb = knope + (size_t)rowk0 * 1024 + hd * 64;
            const bf16_t* kpb = p.kpe + (size_t)rowk0 * 32;
            const bf16_t* vb = vbase + k0;
            rk[0] = *(const u32x4*)(knb + kn_off0); rk[1] = *(const u32x4*)(knb + kn_off1); rk[2] = *(const u32x4*)(kpb + kp_off);
            rv[0] = *(const u32x4*)(vb + v_off0); rv[1] = *(const u32x4*)(vb + v_off1);
        };
        auto lwrite = [&](int buf) {
            bf16_t* Kb = Lb + buf * KVB; bf16_t* Vb = Kb + KT * LDK;
            *(u32x4*)(Kb + kn_lds0) = rk[0]; *(u32x4*)(Kb + kn_lds1) = rk[1]; *(u32x4*)(Kb + kp_lds) = rk[2];
            *(u32x4*)(Vb + v_lds0) = rv[0]; *(u32x4*)(Vb + v_lds1) = rv[1];
        };
        gload(0); lwrite(0); gload(1);
        constexpr int NT = NKEY / KT;
        for (int tile = 0; tile < NT; ++tile) {
            __syncthreads();
            if (tile + 1 < NT) { lwrite((tile + 1) & 1); if (tile + 2 < NT) gload(tile + 2); }
            const bf16_t* Ksm = Lb + (tile & 1) * KVB;
            const bf16_t* Vsm = Ksm + KT * LDK;
#pragma unroll
            for (int ks = 0; ks < 2; ++ks) {
                f32x16 sT[2];
#pragma unroll
                for (int r = 0; r < 16; ++r) { sT[0][r] = 0.f; sT[1][r] = 0.f; }
#pragma unroll
                for (int st = 0; st < 6; ++st) {
                    const bf16x8 kf = *(const bf16x8*)(Ksm + (ks * 32 + l31) * LDK + st * 16 + lh * 8);
                    sT[0] = mfma32(kf, qf[0][st], sT[0]);
                    sT[1] = mfma32(kf, qf[1][st], sT[1]);
                }
                u32x4 pbq[2][2];
#pragma unroll
                for (int qt = 0; qt < 2; ++qt) {
                    float mx = sT[qt][0];
#pragma unroll
                    for (int r = 1; r < 16; ++r) mx = fmaxf(mx, sT[qt][r]);
                    if (__builtin_amdgcn_ballot_w64(mx > mrun[qt] + 8.0f) != 0ull) {
                        mx = fmaxf(mx, __shfl_xor(mx, 32));
                        const float mnew = fmaxf(mrun[qt], mx);
                        const float alpha = __builtin_amdgcn_exp2f(mrun[qt] - mnew);
                        mrun[qt] = mnew;
                        lsum[qt] *= alpha;
#pragma unroll
                        for (int r = 0; r < 16; ++r) { O[qt][0][r] *= alpha; O[qt][1][r] *= alpha; }
                    }
                    float ls4[4] = {0.f, 0.f, 0.f, 0.f};
#pragma unroll
                    for (int r = 0; r < 16; ++r) {
                        const float pe = __builtin_amdgcn_exp2f(sT[qt][r] - mrun[qt]);
                        sT[qt][r] = pe;
                        ls4[r & 3] += pe;
                    }
                    lsum[qt] += (ls4[0] + ls4[1]) + (ls4[2] + ls4[3]);
#pragma unroll
                    for (int ts = 0; ts < 2; ++ts)
                        pbq[qt][ts] = (u32x4){pack_bf16(sT[qt][8 * ts + 0], sT[qt][8 * ts + 1]), pack_bf16(sT[qt][8 * ts + 2], sT[qt][8 * ts + 3]),
                                              pack_bf16(sT[qt][8 * ts + 4], sT[qt][8 * ts + 5]), pack_bf16(sT[qt][8 * ts + 6], sT[qt][8 * ts + 7])};
                }
#pragma unroll
                for (int ts = 0; ts < 2; ++ts)
#pragma unroll
                    for (int vt = 0; vt < 2; ++vt) {
                        const bf16_t* vp = Vsm + (vt * 32 + l31) * LDVT + ks * 32 + 16 * ts + 4 * lh;
                        const u32x2 v0 = *(const u32x2*)vp, v1 = *(const u32x2*)(vp + 8);
                        const bf16x8 va = as_bf16x8((u32x4){v0[0], v0[1], v1[0], v1[1]});
                        O[0][vt] = mfma32(va, as_bf16x8(pbq[0][ts]), O[0][vt]);
                        O[1][vt] = mfma32(va, as_bf16x8(pbq[1][ts]), O[1][vt]);
                    }
            }
        }
#pragma unroll
        for (int qt = 0; qt < 2; ++qt) {
            const float lt = lsum[qt] + __shfl_xor(lsum[qt], 32);
            const float inv = 1.0f / lt;
            bf16_t* op = obuf + (size_t)(m0 + 32 * qt) * 1024 + hd * 64;
#pragma unroll
            for (int vt = 0; vt < 2; ++vt)
#pragma unroll
                for (int g2 = 0; g2 < 2; ++g2) {
                    const int ga = 2 * g2, gb = 2 * g2 + 1;
                    const u32x2 a = {pack_bf16(O[qt][vt][4 * ga] * inv, O[qt][vt][4 * ga + 1] * inv), pack_bf16(O[qt][vt][4 * ga + 2] * inv, O[qt][vt][4 * ga + 3] * inv)};
                    const u32x2 b = {pack_bf16(O[qt][vt][4 * gb] * inv, O[qt][vt][4 * gb + 1] * inv), pack_bf16(O[qt][vt][4 * gb + 2] * inv, O[qt][vt][4 * gb + 3] * inv)};
                    *(u32x4*)(op + vt * 32 + 16 * g2 + 8 * lh) = swap_pair16(a, b);
                }
        }
        __syncthreads();
    }
}

__device__ __forceinline__ void run_phase(const Params& p, int ph, char* smem) {
    bf16_t* cqkv = p.big;
    bf16_t* qbuf = p.big + (size_t)NTOK * CQW;
    bf16_t* knope = qbuf + (size_t)NLAT * 1536;
    bf16_t* obuf = p.big;
    bf16_t* hmid = p.big;
    switch (ph) {
    case 0: if ((PHASE_MASK >> 0) & 1) {
        const int total = 384 + WC0_TILES + 1;
        for (int it = blockIdx.x; it < total; it += gridDim.x) {
            if (it < 384) adaln_item(p, it, smem);
            else if (it < 384 + WC0_TILES) wconv_item(p, 0, it - 384, smem);
            else rope_item(p);
        }
    } break;
    case 1: if ((PHASE_MASK >> 1) & 1) norm_mod_phase(p, 0, 0, 0, 0, NTOK); break;
    case 2: if ((PHASE_MASK >> 2) & 1) { GemmDesc g{p.abuf, DM, p.wt_in0, 1024, 0}; EpiProj0 e{p.big, p.dt_raw, p.rope_ret}; gemm_phase<4, false>(g, NTOK / 256, 29, e, smem); } break;
    case 3: if ((PHASE_MASK >> 3) & 1) conv_phase(p); break;
    case 4: if ((PHASE_MASK >> 4) & 1) scan_state_phase(p, smem); break;
    case 5: if ((PHASE_MASK >> 5) & 1) scan_pass_phase(p); break;
    case 6: if ((PHASE_MASK >> 6) & 1) scan_out_phase(p, smem); break;
    case 7: if ((PHASE_MASK >> 7) & 1) { GemmDesc g{p.big + 1536, P0W, p.wt_out0, 1024, 512}; EpiResid e{p.ctx, p.x, p.hctx, p.out, p.ada + 2 * 1024, 0}; GemmDesc gl = g; gl.A = g.A + (size_t)NCTX * P0W; EpiResid el = e; el.row_off = NCTX;
        TileOrder ord; ord.init(NLAT / 256, 8);
        int tm, tn;
        for (int k = 0; ord.get(k, tm, tn); ++k) gemm_tile<4, true>(gl, tm, tn, el, smem);
        for (int it = blockIdx.x; it < (NCTX / 128) * 8; it += gridDim.x) gemm_tile<2, true>(g, it / 8, it % 8, e, smem);
        } break;
    case 8: if ((PHASE_MASK >> 8) & 1) {
        norm_mod_phase(p, 1, 0, 3, 0, NTOK);
        for (int it = blockIdx.x; it < WC1_TILES; it += gridDim.x) wconv_item(p, 1, it, smem);
    } break;
    case 9: if ((PHASE_MASK >> 9) & 1) { GemmDesc g{p.abuf, DM, p.wt_f1_0, 1024, 0}; EpiSwiglu e{hmid}; gemm_phase<4, false>(g, NTOK / 256, 44, e, smem); } break;
    case 10: if ((PHASE_MASK >> 10) & 1) { GemmDesc g{hmid, DFF, p.wt_f2_0, DFF, 0}; EpiResid e{p.hctx, p.out, p.hctx, p.out, p.ada + 5 * 1024, 0};
        const int tc = (NCTX / 128) * 8 * 4;
        GemmDesc gl = g; gl.A = g.A + (size_t)NCTX * DFF; EpiResid el = e; el.row_off = NCTX;
        EpiResidAtomic ea{p.hctx, p.ada + 5 * 1024};
        {
            TileOrder ord; ord.init(NLAT / 256, 8);
            int tm, tn;
            for (int k = 0; ord.get(k, tm, tn); ++k) gemm_tile<4, false>(gl, tm, tn, el, smem);
        }
        for (int c = blockIdx.x; c < tc; c += gridDim.x) {
            const int tile = c >> 2, ks = c & 3;
            GemmDesc gc = g; gc.A = g.A + ks * (DFF / 4); gc.Bt = g.Bt + ks * (DFF / 4); gc.klen = DFF / 4;
            gemm_tile<2, false>(gc, tile / 8, tile % 8, ea, smem);
        } } break;
    case 11: if ((PHASE_MASK >> 11) & 1) norm_mod_phase(p, 1, 1, 0, 0, NTOK); break;
    case 12: if ((PHASE_MASK >> 12) & 1) { GemmDesc g{p.abuf, DM, p.wt_mla_in, 1024, 0}; EpiCqkv e{cqkv, p.kpe, p.rope_mla}; gemm_phase_tail2(g, NTOK / 256, 9, e, smem); } break;
    case 13: if ((PHASE_MASK >> 13) & 1) {
        GemmDesc gq{cqkv + (size_t)NCTX * CQW, CQW, p.wt_uq, 768, 768}; EpiQ eq{qbuf, p.rope_mla};
        GemmDesc gk{cqkv + 768, CQW, p.wt_ukv, 256, 256}; EpiKV ek{knope, p.abuf};
        const int t1 = (NLAT / 256) * 12, t2 = (NTOK / 256) * 16;
        if (gridDim.x == 512) {
            const int b = blockIdx.x;
            if (b < 256) {
                gemm_tile<4, true>(gq, (2 * b) / 12, (2 * b) % 12, eq, smem);
                gemm_tile<4, true>(gq, (2 * b + 1) / 12, (2 * b + 1) % 12, eq, smem);
                gemm_tile<4, true>(gk, b / 16, b % 16, ek, smem);
            } else {
                const int c = b - 256;
                gemm_tile<4, true>(gq, (512 + c) / 12, (512 + c) % 12, eq, smem);
                for (int k3 = 0; k3 < 3; ++k3) { const int j = 256 + 3 * c + k3; gemm_tile<4, true>(gk, j / 16, j % 16, ek, smem); }
                if (c < 64) { const int j = 1024 + c; gemm_tile<4, true>(gk, j / 16, j % 16, ek, smem); }
            }
        } else {
            for (int it = blockIdx.x; it < t1 + t2; it += gridDim.x) {
                if (it < t1) gemm_tile<4, true>(gq, it / 12, it % 12, eq, smem);
                else { const int i2 = it - t1; gemm_tile<4, true>(gk, i2 / 16, i2 % 16, ek, smem); }
            }
        }
    } break;
    case 14: if ((PHASE_MASK >> 14) & 1) attn_phase(p, qbuf, knope, p.abuf, obuf, smem); break;
    case 15: if ((PHASE_MASK >> 15) & 1) { GemmDesc g{obuf, DM, p.wt_mla_out, 1024, 0}; EpiResid e{p.hctx, p.out, p.hctx, p.out, p.ada + (size_t)5 * 6144 + 2 * 1024, NCTX}; gemm_phase<4, false>(g, NLAT / 256, 8, e, smem); } break;
    case 16: if ((PHASE_MASK >> 16) & 1) norm_mod_phase(p, 1, 1, 3, NCTX, NTOK); break;
    case 17: if ((PHASE_MASK >> 17) & 1) { GemmDesc g{p.abuf + (size_t)NCTX * DM, DM, p.wt_f1_1, 1024, 0}; EpiSwiglu e{hmid}; gemm_phase_tail2(g, NLAT / 256, 44, e, smem); } break;
    case 18: if ((PHASE_MASK >> 18) & 1) { GemmDesc g{hmid, DFF, p.wt_f2_1, DFF, 0}; EpiResid e{p.hctx, p.out, p.hctx, p.out, p.ada + (size_t)5 * 6144 + 5 * 1024, NCTX}; gemm_phase<4, false>(g, NLAT / 256, 8, e, smem); } break;
    case 19: if ((PHASE_MASK >> 19) & 1) final_norm_phase(p); break;
    default: break;
    }
}

constexpr int SMEM_BYTES = (256 + 128) * LDT * 2 + 256 * 4;

__global__ void __launch_bounds__(256, 2) fwd_megakernel(Params p, int ph_lo, int ph_hi) {
    __shared__ __attribute__((aligned(16))) char smem[SMEM_BYTES];
    __shared__ __attribute__((aligned(16))) unsigned xb_words[4];
    cg::grid_group grid = cg::this_grid();
    if (threadIdx.x < 4) xb_words[threadIdx.x] = 0u;
    __syncthreads();
    XcdBarrier xb = xcd_barrier_post(p.bar, xb_words);
    if (ph_hi > 1000) grid.sync();
#ifndef PROBE_DUP
#define PROBE_DUP -1
#endif
#define RUN_PH(N) if (ph_lo <= N && N < ph_hi) { if (N == PROBE_DUP) run_phase(p, N, smem); run_phase(p, N, smem); if (N + 1 < ph_hi) xcd_barrier(xb); }
    RUN_PH(0) RUN_PH(1) RUN_PH(2) RUN_PH(3) RUN_PH(4) RUN_PH(5) RUN_PH(6) RUN_PH(7) RUN_PH(8) RUN_PH(9)
    RUN_PH(10) RUN_PH(11) RUN_PH(12) RUN_PH(13) RUN_PH(14) RUN_PH(15) RUN_PH(16) RUN_PH(17) RUN_PH(18) RUN_PH(19)
#undef RUN_PH
}

extern "C" void kernel_launch(void* const* d_in, const int* in_sizes, int n_in, void* d_out, int out_size, void* d_ws, size_t ws_size, hipStream_t stream) {
    static int grid_blocks = 0;
    if (grid_blocks == 0) {
        int dev = 0, cus = 0, per_cu = 0;
        hipGetDevice(&dev);
        hipDeviceGetAttribute(&cus, hipDeviceAttributeMultiprocessorCount, dev);
        hipOccupancyMaxActiveBlocksPerMultiprocessor(&per_cu, fwd_megakernel, 256, 0);
        if (per_cu < 1) per_cu = 1;
        if (per_cu > 2) per_cu = 2;
        grid_blocks = cus * per_cu;
    }
    Params p{};
    const float* const* in = (const float* const*)d_in;
    p.x = in[0]; p.c = in[1]; p.ctx = in[2]; p.c_ctx = in[3]; p.w_ada = in[4]; p.b_ada = in[5]; p.w_gate = in[6]; p.w_up = in[7]; p.w_down = in[8];
    p.w_in0 = in[9]; p.conv_w = in[10]; p.conv_b = in[11]; p.dt_bias = in[12]; p.a_log = in[13]; p.ssd_d = in[14]; p.ssd_norm_w = in[15];
    p.decay_logit = in[16]; p.gn_w = in[17]; p.w_out0 = in[18]; p.mla_w_in = in[19]; p.q_norm_w = in[20]; p.w_uq = in[21]; p.kv_norm_w = in[22];
    p.w_ukv = in[23]; p.mla_w_out = in[24]; p.final_norm_w = in[25];
    p.out = (float*)d_out;
    char* ws = (char*)d_ws;
    size_t off = 0;
    auto take = [&](size_t bytes) { char* r = ws + off; off += (bytes + 255) & ~(size_t)255; return r; };
    p.wt_in0 = (bf16_t*)take((size_t)3712 * 1024 * 2);
    p.wt_out0 = (bf16_t*)take((size_t)1024 * 1024 * 2);
    p.wt_f1_0 = (bf16_t*)take((size_t)5632 * 1024 * 2);
    p.wt_f2_0 = (bf16_t*)take((size_t)1024 * 2816 * 2);
    p.big = (bf16_t*)take((size_t)NTOK * P0W * 2);
    p.abuf = (bf16_t*)take((size_t)NTOK * 1024 * 2);
    char* states = take((size_t)NITEM / 2 * 2 * 4096 * 2 + (size_t)NITEM / 2 * 2 * 8192 * 2);
    p.st_ret = (bf16_t*)states;
    p.st_ssd = p.st_ret + (size_t)(NITEM / 2) * 2 * 4096;
    {
        char* w1 = states; size_t o1 = 0;
        auto take1 = [&](size_t bytes) { char* r = w1 + o1; o1 += (bytes + 255) & ~(size_t)255; return r; };
        p.wt_mla_in = (bf16_t*)take1((size_t)1152 * 1024 * 2);
        p.wt_uq = (bf16_t*)take1((size_t)1536 * 768 * 2);
        p.wt_ukv = (bf16_t*)take1((size_t)2048 * 256 * 2);
        p.wt_mla_out = (bf16_t*)take1((size_t)1024 * 1024 * 2);
        p.wt_f1_1 = (bf16_t*)take1((size_t)5632 * 1024 * 2);
        p.wt_f2_1 = (bf16_t*)take1((size_t)1024 * 2816 * 2);
    }
    p.hctx = (float*)take((size_t)NCTX * DM * 4);
    p.ada = (float*)take((size_t)2 * 5 * 6144 * 4);
    p.rope_ret = (float*)take(2048 * 4);
    p.rope_mla = (float*)take(1024 * 4);
    p.dt_raw = (float*)take((size_t)NTOK * 16 * 4);
    p.dtv = (float*)take((size_t)NTOK * 16 * 4);
    p.la = (float*)take((size_t)NTOK * 16 * 4);
    p.tot = (float*)take((size_t)NITEM * 2 * 4);
    p.kpe = (bf16_t*)take((size_t)NTOK * 32 * 2);
    p.bar = (unsigned*)take((size_t)XCD_BAR_WORDS * 4);
    if (off > ws_size) { fprintf(stderr, "kernel_launch: workspace too small: need %zu, have %zu\n", off, ws_size); return; }
    for (int f = 0; f < 16; ++f) p.inv_ret[f] = powf(10000.0f, -(float)f / 16.0f);
    for (int f = 0; f < 8; ++f) p.inv_mla[f] = powf(10000.0f, -(float)f / 8.0f);
    hipMemsetAsync(p.bar, 0, (size_t)XCD_BAR_WORDS * 4, stream);
#if SINGLE_LAUNCH
    int lo = 0, hi = NPHASE;
    void* args[] = {&p, &lo, &hi};
    hipError_t e = hipLaunchCooperativeKernel((const void*)fwd_megakernel, dim3(grid_blocks), dim3(256), args, 0, stream);
    if (e != hipSuccess) fprintf(stderr, "cooperative launch failed: %s (grid %d)\n", hipGetErrorString(e), grid_blocks);
#else
    for (int ph = 0; ph < NPHASE; ++ph) hipLaunchKernelGGL(fwd_megakernel, dim3(grid_blocks), dim3(256), 0, stream, p, ph, ph + 1);
#endif
}
```

```cpp
#include <hip/hip_runtime.h>
#include <hip/hip_cooperative_groups.h>
#include <cstdio>
#include <cmath>
namespace cg = cooperative_groups;

#ifndef PHASE_MASK
#define PHASE_MASK 0xFFFFF
#endif
#ifndef SINGLE_LAUNCH
#define SINGLE_LAUNCH 1
#endif

typedef unsigned short bf16_t;
typedef short bf16x8 __attribute__((ext_vector_type(8)));
typedef float f32x16 __attribute__((ext_vector_type(16)));
typedef float f32x4 __attribute__((ext_vector_type(4)));
typedef unsigned u32x4 __attribute__((ext_vector_type(4)));
typedef unsigned u32x2 __attribute__((ext_vector_type(2)));

constexpr int DM = 1024, NBATCH = 4, SEQL = 4096, CTXL = 256;
constexpr int NCTX = NBATCH * CTXL;
constexpr int NLAT = NBATCH * SEQL;
constexpr int NTOK = NCTX + NLAT;
constexpr int DFF = 2816;
constexpr int P0W = 3584;
constexpr int CQW = 1056;
constexpr int NKEY = CTXL + SEQL;
constexpr int NCHUNK = 34;
constexpr int NITEM = NBATCH * NCHUNK * 16;
constexpr float EPS = 1e-6f;
constexpr int NPHASE = 20;

struct Params {
    const float *x, *c, *ctx, *c_ctx, *w_ada, *b_ada, *w_gate, *w_up, *w_down, *w_in0, *conv_w, *conv_b, *dt_bias, *a_log,
        *ssd_d, *ssd_norm_w, *decay_logit, *gn_w, *w_out0, *mla_w_in, *q_norm_w, *w_uq, *kv_norm_w, *w_ukv, *mla_w_out, *final_norm_w;
    float* out;
    bf16_t *wt_in0, *wt_out0, *wt_f1_0, *wt_f2_0;
    bf16_t *wt_mla_in, *wt_uq, *wt_ukv, *wt_mla_out, *wt_f1_1, *wt_f2_1;
    bf16_t *big, *abuf, *st_ret, *st_ssd, *kpe;
    float *hctx, *ada, *rope_ret, *rope_mla, *dt_raw, *dtv, *la, *tot; unsigned* bar;
    float inv_ret[16];
    float inv_mla[8];
};

typedef float f32x2 __attribute__((ext_vector_type(2)));
typedef __bf16 bf16x2_t __attribute__((ext_vector_type(2)));
__device__ __forceinline__ unsigned pack_bf16(float lo, float hi) {
    f32x2 v = {lo, hi};
    union { bf16x2_t b; unsigned u; } x; x.b = __builtin_convertvector(v, bf16x2_t); return x.u;
}
__device__ __forceinline__ bf16_t f2bf(float v) { return (bf16_t)(pack_bf16(v, 0.f) & 0xffffu); }
__device__ __forceinline__ float bf_lo(unsigned u) { return __uint_as_float(u << 16); }
__device__ __forceinline__ float bf_hi(unsigned u) { return __uint_as_float(u & 0xffff0000u); }
__device__ __forceinline__ float bf2f(bf16_t h) { return __uint_as_float(((unsigned)h) << 16); }
__device__ __forceinline__ float silu_f(float v) { return v * __builtin_amdgcn_rcpf(1.0f + __expf(-v)); }
__device__ __forceinline__ float wave_sum(float v) {
    v += __shfl_xor(v, 32); v += __shfl_xor(v, 16); v += __shfl_xor(v, 8);
    v += __shfl_xor(v, 4);  v += __shfl_xor(v, 2);  v += __shfl_xor(v, 1);
    return v;
}
__device__ __forceinline__ f32x16 mfma32(bf16x8 a, bf16x8 b, f32x16 c) { return __builtin_amdgcn_mfma_f32_32x32x16_bf16(a, b, c, 0, 0, 0); }
__device__ __forceinline__ bf16x8 as_bf16x8(u32x4 v) { union { u32x4 u; bf16x8 b; } x; x.u = v; return x.b; }
__device__ __forceinline__ int cond_of_row(int row) { return row < NCTX ? 4 : ((row - NCTX) >> 12); }
__device__ __forceinline__ int crow(int r, int lh) { return (r & 3) + 8 * (r >> 2) + 4 * lh; }


#define XB_TMO      128
#define XB_XCNT(j)  (256  + 64 * (j))
#define XB_XSUB(j)  (1280 + 64 * (j))
#define XB_XGEN(j)  (2304 + 64 * (j))
#define XB_TOP      3328
#define XB_TOPGEN   3392
#define XCD_BAR_WORDS 3456
#define XB_SPIN_CAP (1u << 22)
#define LAS __attribute__((address_space(3)))
__device__ __forceinline__ unsigned xb_ld(unsigned* p)              { return __hip_atomic_load(p, __ATOMIC_RELAXED, __HIP_MEMORY_SCOPE_AGENT); }
__device__ __forceinline__ unsigned xb_add(unsigned* p, unsigned v) { return __hip_atomic_fetch_add(p, v, __ATOMIC_RELAXED, __HIP_MEMORY_SCOPE_AGENT); }
__device__ __forceinline__ unsigned xb_xcc_id() { return (unsigned)__builtin_amdgcn_s_getreg((3 << 11) | 20) & 0xFu; }
#define XB_SPIN(cond, bar) do { unsigned _sp = 0; while (cond) { __builtin_amdgcn_s_sleep(1); \
    if ((++_sp & 255u) == 0u) { if (xb_ld(&(bar)[XB_TMO])) break; if (_sp > XB_SPIN_CAP) { atomicAdd(&(bar)[XB_TMO], 1u); break; } } } } while (0)
struct XcdBarrier { unsigned* bar; unsigned x; volatile unsigned* st; };
__device__ __forceinline__ XcdBarrier xcd_barrier_post(unsigned* bar, volatile unsigned* st) {
    XcdBarrier b; b.bar = bar; b.x = xb_xcc_id(); b.st = st;
    if (threadIdx.x == 0) (void)xb_add(&bar[XB_XCNT(b.x)], 1u);
    return b;
}
__device__ __forceinline__ void xcd_barrier_complete(unsigned* bar, unsigned x, unsigned& nloc, unsigned& nx) {
    const unsigned G = gridDim.x * gridDim.y * gridDim.z;
    unsigned sum, cnt, mine, sp = 0u;
    for (;;) {
        sum = 0u; cnt = 0u; mine = 0u;
#pragma unroll
        for (unsigned j = 0; j < 16; ++j) { const unsigned c = xb_ld(&bar[XB_XCNT(j)]); sum += c; cnt += (c > 0u) ? 1u : 0u; mine = (j == x) ? c : mine; }
        if (sum == G) break;
        __builtin_amdgcn_s_sleep(1);
        if ((++sp & 255u) == 0u) { if (xb_ld(&bar[XB_TMO])) break; if (sp > XB_SPIN_CAP) { atomicAdd(&bar[XB_TMO], 1u); break; } }
    }
    nloc = mine > 0u ? mine : 1u; nx = cnt > 0u ? cnt : 1u;
}
__device__ __forceinline__ void xcd_barrier(const XcdBarrier& b) {
    asm volatile("s_waitcnt vmcnt(0)" ::: "memory");
    __syncthreads();
    if (threadIdx.x == 0) {
        unsigned* bar = b.bar;
        __builtin_amdgcn_s_waitcnt(0);
        unsigned nloc = b.st[0], nx = b.st[1];
        if (nloc == 0u) { xcd_barrier_complete(bar, b.x, nloc, nx); b.st[0] = nloc; b.st[1] = nx; }
        const unsigned old = xb_add(&bar[XB_XSUB(b.x)], 1u);
        const unsigned gen = old / nloc;
        if (old + 1u == (gen + 1u) * nloc) {
            __builtin_amdgcn_fence(__ATOMIC_RELEASE, "agent");
            asm volatile("s_waitcnt vmcnt(0)" ::: "memory");
            const unsigned og = xb_add(&bar[XB_TOP], 1u);
            const unsigned tg = og / nx;
            if (og + 1u == (tg + 1u) * nx) xb_add(&bar[XB_TOPGEN], 1u);
            else XB_SPIN(xb_ld(&bar[XB_TOPGEN]) == tg, bar);
            __builtin_amdgcn_fence(__ATOMIC_ACQUIRE, "agent");
            xb_add(&bar[XB_XGEN(b.x)], 1u);
            asm volatile("s_waitcnt vmcnt(0)" ::: "memory");
        } else {
            XB_SPIN(xb_ld(&bar[XB_XGEN(b.x)]) == gen, bar);
            __builtin_amdgcn_fence(__ATOMIC_ACQUIRE, "agent");
            asm volatile("s_waitcnt vmcnt(0)" ::: "memory");
        }
    }
    __syncthreads();
}

struct WJob { const float* src; const float* src2; const float* kscale; bf16_t* dst; int K, Nsrc, Ndst, mode; };
__device__ __forceinline__ void wconv_tile(const WJob& j, int tk, int tn, char* smem) {
    float* sm = (float*)smem;
    const int t = threadIdx.x;
#pragma unroll
    for (int i = 0; i < 4; ++i) {
        const int kl = (t >> 4) + 16 * i, nq = (t & 15) * 4;
        const int np = tn * 64 + nq, kp = tk * 64 + kl;
        int row = kp, col = np; const float* arr = j.src; bool valid = true; float sc = 1.0f;
        if (j.mode == 0) {
            if (np >= 1536 && np < 2048) col = np + 512; else if (np >= 2048 && np < 2560) col = np - 512;
            if (np >= 3600) valid = false;
        } else if (j.mode == 1) {
            row = kp < 512 ? kp + 512 : kp - 512;
            if (kp < 512) sc = j.kscale[kp];
        } else if (j.mode == 2) {
            const int t128 = np >> 7, wn = (np >> 6) & 1, half = (np >> 5) & 1, cc = np & 31;
            col = t128 * 64 + wn * 32 + cc; arr = half ? j.src2 : j.src;
        } else {
            if (np >= j.Nsrc) valid = false;
            if (j.kscale) sc = j.kscale[kp];
        }
        f32x4 v = {0.f, 0.f, 0.f, 0.f};
        if (valid) v = *(const f32x4*)(arr + (size_t)row * j.Nsrc + col);
        sm[kl * 65 + nq + 0] = v[0] * sc; sm[kl * 65 + nq + 1] = v[1] * sc; sm[kl * 65 + nq + 2] = v[2] * sc; sm[kl * 65 + nq + 3] = v[3] * sc;
    }
    __syncthreads();
    {
        const int nl = t >> 2, ks = (t & 3) * 16;
        unsigned w[8];
#pragma unroll
        for (int e = 0; e < 8; ++e) w[e] = pack_bf16(sm[(ks + 2 * e) * 65 + nl], sm[(ks + 2 * e + 1) * 65 + nl]);
        bf16_t* d = j.dst + (size_t)(tn * 64 + nl) * j.K + tk * 64 + ks;
        *(u32x4*)d = (u32x4){w[0], w[1], w[2], w[3]};
        *(u32x4*)(d + 8) = (u32x4){w[4], w[5], w[6], w[7]};
    }
    __syncthreads();
}
__device__ __forceinline__ void mk_job(WJob& j, const float* src, const float* src2, const float* ks, bf16_t* dst, int K, int Nsrc, int Ndst, int mode) {
    j.src = src; j.src2 = src2; j.kscale = ks; j.dst = dst; j.K = K; j.Nsrc = Nsrc; j.Ndst = Ndst; j.mode = mode;
}
constexpr int WC0_TILES = 928 + 256 + 1408 + 704;
constexpr int WC1_TILES = 288 + 288 + 128 + 256 + 1408 + 704;
__device__ __forceinline__ void wconv_item(const Params& p, int set, int idx, char* smem) {
    WJob j;
    if (set == 0) {
        if (idx < 928) mk_job(j, p.w_in0, nullptr, nullptr, p.wt_in0, 1024, 3600, 3712, 0);
        else if ((idx -= 928) < 256) mk_job(j, p.w_out0, nullptr, p.ssd_norm_w, p.wt_out0, 1024, 1024, 1024, 1);
        else if ((idx -= 256) < 1408) mk_job(j, p.w_gate, p.w_up, nullptr, p.wt_f1_0, 1024, 2816, 5632, 2);
        else { idx -= 1408; mk_job(j, p.w_down, nullptr, nullptr, p.wt_f2_0, 2816, 1024, 1024, 3); }
    } else {
        if (idx < 288) mk_job(j, p.mla_w_in, nullptr, nullptr, p.wt_mla_in, 1024, 1056, 1152, 3);
        else if ((idx -= 288) < 288) mk_job(j, p.w_uq, nullptr, p.q_norm_w, p.wt_uq, 768, 1536, 1536, 3);
        else if ((idx -= 288) < 128) mk_job(j, p.w_ukv, nullptr, p.kv_norm_w, p.wt_ukv, 256, 2048, 2048, 3);
        else if ((idx -= 128) < 256) mk_job(j, p.mla_w_out, nullptr, nullptr, p.wt_mla_out, 1024, 1024, 1024, 3);
        else if ((idx -= 256) < 1408) mk_job(j, p.w_gate + (size_t)1024 * 2816, p.w_up + (size_t)1024 * 2816, nullptr, p.wt_f1_1, 1024, 2816, 5632, 2);
        else { idx -= 1408; mk_job(j, p.w_down + (size_t)2816 * 1024, nullptr, nullptr, p.wt_f2_1, 2816, 1024, 1024, 3); }
    }
    const int nkt = j.K / 64;
    wconv_tile(j, idx % nkt, idx / nkt, smem);
}

__device__ __forceinline__ void adaln_item(const Params& p, int a, char* smem) {
    float* sc = (float*)smem;
    float* red = sc + 5 * 1024;
    const int t = threadIdx.x;
    const int layer = a / 192, cb = a % 192;
    for (int i = t; i < 5 * 1024; i += 256) {
        const int cnd = i >> 10, k = i & 1023;
        const float v = cnd < 4 ? p.c[cnd * 1024 + k] : p.c_ctx[k];
        sc[i] = silu_f(v);
    }
    __syncthreads();
    const int kq = t >> 3, cq = t & 7;
    const int col = cb * 32 + cq * 4;
    float acc[5][4];
#pragma unroll
    for (int cnd = 0; cnd < 5; ++cnd) { acc[cnd][0] = acc[cnd][1] = acc[cnd][2] = acc[cnd][3] = 0.f; }
    const float* wp = p.w_ada + (size_t)layer * 1024 * 6144 + col;
#pragma unroll 4
    for (int kk = 0; kk < 32; ++kk) {
        const int k = kq + 32 * kk;
        const f32x4 w = *(const f32x4*)(wp + (size_t)k * 6144);
#pragma unroll
        for (int cnd = 0; cnd < 5; ++cnd) {
            const float s = sc[cnd * 1024 + k];
            acc[cnd][0] += s * w[0]; acc[cnd][1] += s * w[1]; acc[cnd][2] += s * w[2]; acc[cnd][3] += s * w[3];
        }
    }
#pragma unroll
    for (int cnd = 0; cnd < 5; ++cnd)
#pragma unroll
        for (int e = 0; e < 4; ++e) red[(kq * 8 + cq) * 20 + cnd * 4 + e] = acc[cnd][e];
    __syncthreads();
    if (t < 160) {
        const int cnd = t >> 5, cl = t & 31;
        float s = p.b_ada[layer * 6144 + cb * 32 + cl];
        for (int q = 0; q < 32; ++q) s += red[(q * 8 + (cl >> 2)) * 20 + cnd * 4 + (cl & 3)];
        p.ada[(size_t)(layer * 5 + cnd) * 6144 + cb * 32 + cl] = s;
    }
    __syncthreads();
}

__device__ __forceinline__ void sincos_acc(float xf, float& s, float& c) {
    const double x = (double)xf;
    const double k = rint(x * 0.63661977236758134308);
    const double r = x - k * 1.57079632679489661923;
    const double r2 = r * r;
    double sp = r * (1.0 + r2 * (-1.0 / 6 + r2 * (1.0 / 120 + r2 * (-1.0 / 5040 + r2 * (1.0 / 362880 + r2 * (-1.0 / 39916800 + r2 * (1.0 / 6227020800.0)))))));
    double cp = 1.0 + r2 * (-0.5 + r2 * (1.0 / 24 + r2 * (-1.0 / 720 + r2 * (1.0 / 40320 + r2 * (-1.0 / 3628800 + r2 * (1.0 / 479001600.0 + r2 * (-1.0 / 87178291200.0)))))));
    const int q = ((int)k) & 3;
    double ss, cc;
    if (q == 0) { ss = sp; cc = cp; } else if (q == 1) { ss = cp; cc = -sp; } else if (q == 2) { ss = -sp; cc = -cp; } else { ss = -cp; cc = sp; }
    s = (float)ss; c = (float)cc;
}
__device__ __forceinline__ void rope_item(const Params& p) {
    for (int i = threadIdx.x; i < 1024 + 512; i += 256) {
        float s, c;
        if (i < 1024) { const int pos = i >> 4, f = i & 15; sincos_acc((float)pos * p.inv_ret[f], s, c); p.rope_ret[i] = c; p.rope_ret[1024 + i] = s; }
        else { const int ii = i - 1024, pos = ii >> 3, f = ii & 7; sincos_acc((float)pos * p.inv_mla[f], s, c); p.rope_mla[ii] = c; p.rope_mla[512 + ii] = s; }
    }
}

__device__ __forceinline__ void norm_mod_phase(const Params& p, int src_mode, int layer, int shift_chunk, int row0, int row1) {
    const int lane = threadIdx.x & 63, w = threadIdx.x >> 6;
    for (int row = row0 + blockIdx.x * 4 + w; row < row1; row += gridDim.x * 4) {
        const float* src;
        if (row < NCTX) src = (src_mode == 0 ? p.ctx : p.hctx) + (size_t)row * DM;
        else src = (src_mode == 0 ? p.x : p.out) + (size_t)(row - NCTX) * DM;
        f32x4 v[4]; float ss = 0.f;
#pragma unroll
        for (int i = 0; i < 4; ++i) { v[i] = *(const f32x4*)(src + (lane + 64 * i) * 4); ss += v[i][0] * v[i][0] + v[i][1] * v[i][1] + v[i][2] * v[i][2] + v[i][3] * v[i][3]; }
        ss = wave_sum(ss);
        const float r = rsqrtf(ss * (1.0f / DM) + EPS);
        const float* ad = p.ada + (size_t)(layer * 5 + cond_of_row(row)) * 6144;
        const float* shp = ad + shift_chunk * 1024;
        const float* scp = ad + (shift_chunk + 1) * 1024;
        bf16_t* dst = p.abuf + (size_t)row * DM;
        f32x4 sh[4], sc[4];
#pragma unroll
        for (int i = 0; i < 4; ++i) { sh[i] = *(const f32x4*)(shp + (lane + 64 * i) * 4); sc[i] = *(const f32x4*)(scp + (lane + 64 * i) * 4); }
        u32x2 o[4];
#pragma unroll
        for (int i = 0; i < 4; ++i) {
            const float y0 = v[i][0] * r * (1.f + sc[i][0]) + sh[i][0], y1 = v[i][1] * r * (1.f + sc[i][1]) + sh[i][1];
            const float y2 = v[i][2] * r * (1.f + sc[i][2]) + sh[i][2], y3 = v[i][3] * r * (1.f + sc[i][3]) + sh[i][3];
            o[i] = (u32x2){pack_bf16(y0, y1), pack_bf16(y2, y3)};
        }
#pragma unroll
        for (int i = 0; i < 4; ++i) *(u32x2*)(dst + (lane + 64 * i) * 4) = o[i];
    }
}
__device__ __forceinline__ void final_norm_phase(const Params& p) {
    const int lane = threadIdx.x & 63, w = threadIdx.x >> 6;
    for (int row = blockIdx.x * 4 + w; row < NLAT; row += gridDim.x * 4) {
        float* src = p.out + (size_t)row * DM;
        f32x4 v[4]; float ss = 0.f;
#pragma unroll
        for (int i = 0; i < 4; ++i) { v[i] = *(const f32x4*)(src + (lane + 64 * i) * 4); ss += v[i][0] * v[i][0] + v[i][1] * v[i][1] + v[i][2] * v[i][2] + v[i][3] * v[i][3]; }
        ss = wave_sum(ss);
        const float r = rsqrtf(ss * (1.0f / DM) + EPS);
        f32x4 wv[4];
#pragma unroll
        for (int i = 0; i < 4; ++i) wv[i] = *(const f32x4*)(p.final_norm_w + (lane + 64 * i) * 4);
#pragma unroll
        for (int i = 0; i < 4; ++i) v[i] = (f32x4){v[i][0] * r * wv[i][0], v[i][1] * r * wv[i][1], v[i][2] * r * wv[i][2], v[i][3] * r * wv[i][3]};
#pragma unroll
        for (int i = 0; i < 4; ++i) *(f32x4*)(src + (lane + 64 * i) * 4) = v[i];
    }
}

struct GemmDesc { const bf16_t* A; int lda; const bf16_t* Bt; int K; int Ks; int klen; };
constexpr int LDT = 72;

template <int MI, bool RS, class Epi>
__device__ __forceinline__ void gemm_tile(const GemmDesc& g, int tm, int tn, const Epi& epi, char* smem) {
    constexpr int BM = MI * 64;
    constexpr int NA = MI * 2;
    bf16_t* As = (bf16_t*)smem;
    bf16_t* Bs = As + BM * LDT;
    float* rsc = (float*)(smem + (BM + 128) * LDT * 2);
    const int t = threadIdx.x, lane = t & 63, w = __builtin_amdgcn_readfirstlane(t >> 6), wm = w >> 1, wn = w & 1;
    const int l31 = lane & 31, lh = lane >> 5;
    f32x16 acc[MI][2];
#pragma unroll
    for (int mi = 0; mi < MI; ++mi)
#pragma unroll
        for (int ni = 0; ni < 2; ++ni)
#pragma unroll
            for (int r = 0; r < 16; ++r) acc[mi][ni][r] = 0.f;
    const int lrow = t >> 3, lkc = (t & 7) * 8;
    const bf16_t* Ag = g.A + (size_t)(tm * BM + lrow) * g.lda + lkc;
    const bf16_t* Bg = g.Bt + (size_t)(tn * 128 + lrow) * g.K + lkc;
    u32x4 ra[NA], rb[4];
    float ss[NA];
#pragma unroll
    for (int i = 0; i < NA; ++i) ss[i] = 0.f;
#pragma unroll
    for (int i = 0; i < NA; ++i) ra[i] = *(const u32x4*)(Ag + (size_t)(32 * i) * g.lda);
#pragma unroll
    for (int i = 0; i < 4; ++i) rb[i] = *(const u32x4*)(Bg + (size_t)(32 * i) * g.K);
    const int nk = (g.klen ? g.klen : g.K) / 64;
    for (int kt = 0; kt < nk; ++kt) {
        if (kt) __syncthreads();
#pragma unroll
        for (int i = 0; i < NA; ++i) *(u32x4*)(As + (lrow + 32 * i) * LDT + lkc) = ra[i];
#pragma unroll
        for (int i = 0; i < 4; ++i) *(u32x4*)(Bs + (lrow + 32 * i) * LDT + lkc) = rb[i];
        if (RS) {
            if (kt * 64 < g.Ks) {
#pragma unroll
                for (int i = 0; i < NA; ++i)
#pragma unroll
                    for (int e = 0; e < 4; ++e) { const float a = bf_lo(ra[i][e]), b = bf_hi(ra[i][e]); ss[i] += a * a + b * b; }
            }
            if ((kt + 1) * 64 == g.Ks) {
#pragma unroll
                for (int i = 0; i < NA; ++i) {
                    float s = ss[i];
                    s += __shfl_xor(s, 1); s += __shfl_xor(s, 2); s += __shfl_xor(s, 4);
                    if ((t & 7) == 0) rsc[lrow + 32 * i] = rsqrtf(s / (float)g.Ks + EPS);
                }
            }
        }
        __syncthreads();
        if (kt + 1 < nk) {
            const int k0 = (kt + 1) * 64;
#pragma unroll
            for (int i = 0; i < NA; ++i) ra[i] = *(const u32x4*)(Ag + (size_t)(32 * i) * g.lda + k0);
#pragma unroll
            for (int i = 0; i < 4; ++i) rb[i] = *(const u32x4*)(Bg + (size_t)(32 * i) * g.K + k0);
        }
#pragma unroll
        for (int kk = 0; kk < 4; ++kk) {
            bf16x8 af[MI], bfr[2];
#pragma unroll
            for (int mi = 0; mi < MI; ++mi) af[mi] = *(const bf16x8*)(As + (wm * (MI * 32) + mi * 32 + l31) * LDT + kk * 16 + lh * 8);
#pragma unroll
            for (int ni = 0; ni < 2; ++ni) bfr[ni] = *(const bf16x8*)(Bs + (wn * 64 + ni * 32 + l31) * LDT + kk * 16 + lh * 8);
#pragma unroll
            for (int mi = 0; mi < MI; ++mi)
#pragma unroll
                for (int ni = 0; ni < 2; ++ni) acc[mi][ni] = mfma32(af[mi], bfr[ni], acc[mi][ni]);
        }
        if (RS) {
            if ((kt + 1) * 64 == g.Ks) {
#pragma unroll
                for (int mi = 0; mi < MI; ++mi) {
#pragma unroll
                    for (int g4 = 0; g4 < 4; ++g4) {
                        const f32x4 sv = *(const f32x4*)(rsc + wm * (MI * 32) + mi * 32 + 8 * g4 + 4 * lh);
#pragma unroll
                        for (int e = 0; e < 4; ++e) { acc[mi][0][4 * g4 + e] *= sv[e]; acc[mi][1][4 * g4 + e] *= sv[e]; }
                    }
                    asm volatile("" ::: "memory");
                }
            }
        }
    }
    if (Epi::USES_LDS) __syncthreads();
    epi.template operator()<MI, 0>(acc, tm * BM + wm * (MI * 32), tn * 128 + wn * 64, tn, wn, l31, lh, smem, w);
    if (MI == 4) epi.template operator()<MI, MI - 2>(acc, tm * BM + wm * (MI * 32) + 64, tn * 128 + wn * 64, tn, wn, l31, lh, smem, w);
    __syncthreads();
}


__device__ __forceinline__ u32x4 swap_pair16(u32x2 a  , u32x2 b  ) {
    const auto r0 = __builtin_amdgcn_permlane32_swap(a[0], b[0], false, false);
    const auto r1 = __builtin_amdgcn_permlane32_swap(a[1], b[1], false, false);
    return (u32x4){r0[0], r1[0], r0[1], r1[1]};
}
__device__ __forceinline__ void unswap_pair16(u32x4 wv, u32x2& a, u32x2& b) {
    const auto r0 = __builtin_amdgcn_permlane32_swap(wv[0], wv[2], false, false);
    const auto r1 = __builtin_amdgcn_permlane32_swap(wv[1], wv[3], false, false);
    a = (u32x2){r0[0], r1[0]}; b = (u32x2){r0[1], r1[1]};
}
constexpr int SLD = 68;
__device__ __forceinline__ void stage_store64(float* stg, const f32x16& a0, const f32x16& a1, bf16_t* dst, size_t ld, int l31, int lh) {
#pragma unroll
    for (int r = 0; r < 16; ++r) { stg[crow(r, lh) * SLD + l31] = a0[r]; stg[crow(r, lh) * SLD + 32 + l31] = a1[r]; }
    asm volatile("s_waitcnt lgkmcnt(0)" ::: "memory");
    const int lane = l31 + 32 * lh, rr = lane >> 3, c8 = (lane & 7) * 8;
#pragma unroll
    for (int i = 0; i < 4; ++i) {
        const f32x4 x = *(const f32x4*)(stg + (rr + 8 * i) * SLD + c8), y = *(const f32x4*)(stg + (rr + 8 * i) * SLD + c8 + 4);
        *(u32x4*)(dst + (size_t)(rr + 8 * i) * ld + c8) = (u32x4){pack_bf16(x[0], x[1]), pack_bf16(x[2], x[3]), pack_bf16(y[0], y[1]), pack_bf16(y[2], y[3])};
    }
    asm volatile("s_waitcnt lgkmcnt(0)" ::: "memory");
}
__device__ __forceinline__ void stage_store32(float* stg, const f32x16& a0, bf16_t* dst, size_t ld, int l31, int lh) {
#pragma unroll
    for (int r = 0; r < 16; ++r) stg[crow(r, lh) * SLD + l31] = a0[r];
    asm volatile("s_waitcnt lgkmcnt(0)" ::: "memory");
    const int lane = l31 + 32 * lh, rr = lane >> 2, c8 = (lane & 3) * 8;
#pragma unroll
    for (int i = 0; i < 2; ++i) {
        const f32x4 x = *(const f32x4*)(stg + (rr + 16 * i) * SLD + c8), y = *(const f32x4*)(stg + (rr + 16 * i) * SLD + c8 + 4);
        *(u32x4*)(dst + (size_t)(rr + 16 * i) * ld + c8) = (u32x4){pack_bf16(x[0], x[1]), pack_bf16(x[2], x[3]), pack_bf16(y[0], y[1]), pack_bf16(y[2], y[3])};
    }
    asm volatile("s_waitcnt lgkmcnt(0)" ::: "memory");
}
struct EpiProj0 {
    static constexpr bool USES_LDS = true;
    bf16_t* proj; float* dt_raw; const float* rope;
    template <int MI, int MO> __device__ __forceinline__ void operator()(const f32x16 (&acc)[MI][2], int mbase, int nbase, int tn, int wn, int l31, int lh, char* smem, int w) const {
        float* stg = (float*)smem + w * (32 * SLD);
        if (nbase >= P0W) {
            if (nbase == P0W && l31 < 16) {
#pragma unroll
                for (int mi = 0; mi < 2; ++mi)
#pragma unroll
                    for (int r = 0; r < 16; ++r) dt_raw[(size_t)(mbase + mi * 32 + crow(r, lh)) * 16 + l31] = acc[MO + mi][0][r];
            }
            return;
        }
        if (nbase < 1024) {
            const float sc = nbase >= 512 ? 0.125f : 1.0f;
            const bool lat = mbase >= NCTX;
#pragma unroll
            for (int mi = 0; mi < 2; ++mi) {
                f32x16 y1, y2;
#pragma unroll
                for (int r = 0; r < 16; ++r) {
                    const int row = mbase + mi * 32 + crow(r, lh);
                    float x1 = acc[MO + mi][0][r] * sc, x2 = acc[MO + mi][1][r] * sc;
                    if (lat) {
                        const int pp = (row - NCTX) & (SEQL - 1);
                        const int pos = l31 < 16 ? (pp >> 6) : (pp & 63);
                        const float c = rope[pos * 16 + (l31 & 15)], sn = rope[1024 + pos * 16 + (l31 & 15)];
                        const float t1 = x1 * c - x2 * sn, t2 = x1 * sn + x2 * c; x1 = t1; x2 = t2;
                    }
                    y1[r] = x1; y2[r] = x2;
                }
                stage_store64(stg, y1, y2, proj + (size_t)(mbase + mi * 32) * P0W + nbase, P0W, l31, lh);
            }
            return;
        }
#pragma unroll
        for (int mi = 0; mi < 2; ++mi) stage_store64(stg, acc[MO + mi][0], acc[MO + mi][1], proj + (size_t)(mbase + mi * 32) * P0W + nbase, P0W, l31, lh);
    }
};
struct EpiResid {
    static constexpr bool USES_LDS = true;
    const float* hin_ctx; const float* hin_lat; float* hout_ctx; float* hout_lat; const float* gate_base  ; int row_off;
    template <int MI, int MO> __device__ __forceinline__ void operator()(const f32x16 (&acc)[MI][2], int mbase, int nbase, int tn, int wn, int l31, int lh, char* smem, int w) const {
        const int grow0 = mbase + row_off;
        const float* gp = gate_base + (size_t)cond_of_row(grow0) * 6144;
        const float* hin; float* hout;
        if (grow0 < NCTX) { hin = hin_ctx + (size_t)grow0 * DM; hout = hout_ctx + (size_t)grow0 * DM; }
        else { hin = hin_lat + (size_t)(grow0 - NCTX) * DM; hout = hout_lat + (size_t)(grow0 - NCTX) * DM; }
        float* stg = (float*)smem + w * (32 * SLD);
        const int lane = l31 + 32 * lh;
        const int rr = lane >> 4, c4 = (lane & 15) * 4;
        const f32x4 gt4 = *(const f32x4*)(gp + nbase + c4);
        const int goff = rr * DM + nbase + c4;
#pragma unroll
        for (int mi = 0; mi < 2; ++mi) {
#pragma unroll
            for (int ni = 0; ni < 2; ++ni)
#pragma unroll
                for (int r = 0; r < 16; ++r) stg[crow(r, lh) * SLD + ni * 32 + l31] = acc[MO + mi][ni][r];
            asm volatile("s_waitcnt lgkmcnt(0)" ::: "memory");
#pragma unroll
            for (int i = 0; i < 8; ++i) {
                const f32x4 a = *(const f32x4*)(stg + (rr + 4 * i) * SLD + c4);
                const size_t ro = (size_t)(mi * 32 + 4 * i) * DM;
                const f32x4 hv = *(const f32x4*)(hin + ro + goff);
                *(f32x4*)(hout + ro + goff) = (f32x4){hv[0] + gt4[0] * a[0], hv[1] + gt4[1] * a[1], hv[2] + gt4[2] * a[2], hv[3] + gt4[3] * a[3]};
            }
            asm volatile("s_waitcnt lgkmcnt(0)" ::: "memory");
        }
    }
};
struct EpiResidAtomic {
    static constexpr bool USES_LDS = false;
    float* hout_ctx; const float* gate_base;
    template <int MI, int MO> __device__ __forceinline__ void operator()(const f32x16 (&acc)[MI][2], int mbase, int nbase, int tn, int wn, int l31, int lh, char* smem, int w) const {
        const float* gp = gate_base + (size_t)cond_of_row(mbase) * 6144;
        float* hout = hout_ctx + (size_t)mbase * DM;
        const int loff = 4 * lh * DM + nbase + l31;
#pragma unroll
        for (int ni = 0; ni < 2; ++ni) {
            const float gt = gp[nbase + ni * 32 + l31];
#pragma unroll
            for (int mi = 0; mi < 2; ++mi) {
#pragma unroll
                for (int r = 0; r < 16; ++r) {
                    const size_t ro = (size_t)(mi * 32 + (r & 3) + 8 * (r >> 2)) * DM + ni * 32;
                    unsafeAtomicAdd(hout + ro + loff, gt * acc[MO + mi][ni][r]);
                }
            }
        }
    }
};
struct EpiSwiglu {
    static constexpr bool USES_LDS = true;
    bf16_t* hmid;
    template <int MI, int MO> __device__ __forceinline__ void operator()(const f32x16 (&acc)[MI][2], int mbase, int nbase, int tn, int wn, int l31, int lh, char* smem, int w) const {
        float* stg = (float*)smem + w * (32 * SLD);
#pragma unroll
        for (int mi = 0; mi < 2; ++mi) {
            f32x16 hv;
#pragma unroll
            for (int r = 0; r < 16; ++r) hv[r] = silu_f(acc[MO + mi][0][r]) * acc[MO + mi][1][r];
            stage_store32(stg, hv, hmid + (size_t)(mbase + mi * 32) * DFF + tn * 64 + wn * 32, DFF, l31, lh);
        }
    }
};
struct EpiCqkv {
    static constexpr bool USES_LDS = true;
    bf16_t* cqkv; bf16_t* kpe; const float* rope;
    template <int MI, int MO> __device__ __forceinline__ void operator()(const f32x16 (&acc)[MI][2], int mbase, int nbase, int tn, int wn, int l31, int lh, char* smem, int w) const {
#pragma unroll
        for (int ni = 0; ni < 2; ++ni) {
            const int c0 = nbase + ni * 32;
            if (c0 >= CQW) continue;
            if (c0 == 1024) {
                const bool lat = mbase >= NCTX;
#pragma unroll
                for (int mi = 0; mi < 2; ++mi)
#pragma unroll
                    for (int r = 0; r < 16; ++r) {
                        const int row = mbase + mi * 32 + crow(r, lh);
                        float v = acc[MO + mi][ni][r];
                        if (lat) {
                            const float o = __shfl_xor(v, 16);
                            const int pp = (row - NCTX) & (SEQL - 1);
                            const int i = l31 & 15;
                            const int pos = i < 8 ? (pp >> 6) : (pp & 63);
                            const float c = rope[pos * 8 + (i & 7)], s = rope[512 + pos * 8 + (i & 7)];
                            v = (l31 < 16) ? (v * c - o * s) : (o * s + v * c);
                        }
                        kpe[(size_t)row * 32 + l31] = f2bf(v);
                    }
            } else {
                float* stg = (float*)smem + w * (32 * SLD);
#pragma unroll
                for (int mi = 0; mi < 2; ++mi) stage_store32(stg, acc[MO + mi][ni], cqkv + (size_t)(mbase + mi * 32) * CQW + c0, CQW, l31, lh);
            }
        }
    }
};
struct EpiQ {
    static constexpr bool USES_LDS = true;
    bf16_t* q; const float* rope;
    template <int MI, int MO> __device__ __forceinline__ void operator()(const f32x16 (&acc)[MI][2], int mbase, int nbase, int tn, int wn, int l31, int lh, char* smem, int w) const {
        const float qs = 0.10206207261596575f * 1.4426950408889634f;
        float* stg = (float*)smem + w * (32 * SLD);
#pragma unroll
        for (int ni = 0; ni < 2; ++ni) {
            const int c0 = nbase + ni * 32;
            const bool is_rope = ((c0 >> 5) % 3) == 2;
#pragma unroll
            for (int mi = 0; mi < 2; ++mi) {
                f32x16 y;
#pragma unroll
                for (int r = 0; r < 16; ++r) {
                    const int row = mbase + mi * 32 + crow(r, lh);
                    float v = acc[MO + mi][ni][r] * qs;
                    if (is_rope) {
                        const float o = __shfl_xor(v, 16);
                        const int pp = row & (SEQL - 1);
                        const int i = l31 & 15;
                        const int pos = i < 8 ? (pp >> 6) : (pp & 63);
                        const float c = rope[pos * 8 + (i & 7)], sn = rope[512 + pos * 8 + (i & 7)];
                        v = (l31 < 16) ? (v * c - o * sn) : (o * sn + v * c);
                    }
                    y[r] = v;
                }
                stage_store32(stg, y, q + (size_t)(mbase + mi * 32) * 1536 + c0, 1536, l31, lh);
            }
        }
    }
};
struct EpiKV {
    static constexpr bool USES_LDS = true;
    bf16_t* knope; bf16_t* vt;
    template <int MI, int MO> __device__ __forceinline__ void operator()(const f32x16 (&acc)[MI][2], int mbase, int nbase, int tn, int wn, int l31, int lh, char* smem, int w) const {
        const int head = tn;
        if (wn == 0) {
            float* stg = (float*)smem + w * (32 * SLD);
#pragma unroll
            for (int mi = 0; mi < 2; ++mi) stage_store64(stg, acc[MO + mi][0], acc[MO + mi][1], knope + (size_t)(mbase + mi * 32) * 1024 + head * 64, 1024, l31, lh);
        } else {
            int b, key0;
            if (mbase < NCTX) { b = mbase >> 8; key0 = mbase & 255; } else { b = (mbase - NCTX) >> 12; key0 = CTXL + ((mbase - NCTX) & (SEQL - 1)); }
#pragma unroll
            for (int mi = 0; mi < 2; ++mi)
#pragma unroll
                for (int ni = 0; ni < 2; ++ni) {
                    bf16_t* vp = vt + ((size_t)(b * 16 + head) * 64 + ni * 32 + l31) * NKEY + key0 + mi * 32 + 8 * lh;
#pragma unroll
                    for (int g2 = 0; g2 < 2; ++g2) {
                        const int ga = 2 * g2, gb = 2 * g2 + 1;
                        const u32x2 a = {pack_bf16(acc[MO + mi][ni][4 * ga], acc[MO + mi][ni][4 * ga + 1]), pack_bf16(acc[MO + mi][ni][4 * ga + 2], acc[MO + mi][ni][4 * ga + 3])};
                        const u32x2 bq = {pack_bf16(acc[MO + mi][ni][4 * gb], acc[MO + mi][ni][4 * gb + 1]), pack_bf16(acc[MO + mi][ni][4 * gb + 2], acc[MO + mi][ni][4 * gb + 3])};
                        *(u32x4*)(vp + 16 * g2) = swap_pair16(a, bq);
                    }
                }
        }
    }
};


struct TileOrder {
    int total, per, x, j, nt, mt;
    __device__ __forceinline__ void init(int mt_, int nt_) { mt = mt_; nt = nt_; total = mt_ * nt_; per = (total + 7) >> 3; x = blockIdx.x & 7; j = blockIdx.x >> 3; }
    __device__ __forceinline__ bool get(int k, int& tm, int& tn) const { return at(k * (int)(gridDim.x >> 3) + j, tm, tn); }
    __device__ __forceinline__ bool at(int li, int& tm, int& tn) const {
        if (li >= per) return false;
        const int lin = x * per + li;
        if (lin >= total) return false;
        constexpr int GM = 4;
        const int gsz = GM * nt, gid = lin / gsz, within = lin - gid * gsz;
        const int rem = mt - gid * GM, gm = rem < GM ? rem : GM;
        tm = gid * GM + within % gm; tn = within / gm;
        return true;
    }
};
template <int MI, bool RS, class Epi>
__device__ __forceinline__ void gemm_phase(const GemmDesc& g, int mt, int nt, const Epi& epi, char* smem) {
    TileOrder ord; ord.init(mt, nt);
    int tm, tn;
    for (int k = 0; ord.get(k, tm, tn); ++k) gemm_tile<MI, RS>(g, tm, tn, epi, smem);
}
template <class Epi>
__device__ __forceinline__ void gemm_phase_tail2(const GemmDesc& g, int mt, int nt, const Epi& epi, char* smem) {
    TileOrder ord; ord.init(mt, nt);
    const int slots = gridDim.x >> 3;
    const int R = ord.per / slots, tailn = ord.per - R * slots;
    const bool split = tailn > 0 && 2 * tailn <= slots;
    int tm, tn;
    for (int k = 0; k < (split ? R : R + 1); ++k) { if (ord.get(k, tm, tn)) gemm_tile<4, false>(g, tm, tn, epi, smem); }
    if (split && ord.j < 2 * tailn) {
        const int lin = ord.x * ord.per + R * slots + (ord.j >> 1);
        if (lin < ord.total) {
            constexpr int GM = 4;
            const int gsz = GM * nt, gid = lin / gsz, within = lin - gid * gsz;
            const int rem = mt - gid * GM, gm = rem < GM ? rem : GM;
            tm = gid * GM + within % gm; tn = within / gm;
            gemm_tile<2, false>(g, tm * 2 + (ord.j & 1), tn, epi, smem);
        }
    }
}

__device__ __forceinline__ void conv_phase(const Params& p) {
    const bf16_t* proj = p.big;
    bf16_t* xact = p.abuf;
    const long total = (long)NTOK * 128;
    for (long idx = (long)blockIdx.x * 256 + threadIdx.x; idx < total; idx += (long)gridDim.x * 256) {
        const int row = (int)(idx >> 7), c8 = ((int)idx & 127) * 8;
        int tpos, len;
        if (row < NCTX) { tpos = row & (CTXL - 1); len = CTXL; } else { tpos = (row - NCTX) & (SEQL - 1); len = SEQL; }
        float a[8];
        { const f32x4 b0 = *(const f32x4*)(p.conv_b + c8), b1 = *(const f32x4*)(p.conv_b + c8 + 4);
          a[0] = b0[0]; a[1] = b0[1]; a[2] = b0[2]; a[3] = b0[3]; a[4] = b1[0]; a[5] = b1[1]; a[6] = b1[2]; a[7] = b1[3]; }
#pragma unroll
        for (int j = 0; j < 5; ++j) {
            const int tt = tpos + j - 2;
            if (tt < 0 || tt >= len) continue;
            const u32x4 xv = *(const u32x4*)(proj + (size_t)(row + j - 2) * P0W + 2560 + c8);
            const f32x4 w0 = *(const f32x4*)(p.conv_w + j * 1024 + c8), w1 = *(const f32x4*)(p.conv_w + j * 1024 + c8 + 4);
            a[0] += w0[0] * bf_lo(xv[0]); a[1] += w0[1] * bf_hi(xv[0]); a[2] += w0[2] * bf_lo(xv[1]); a[3] += w0[3] * bf_hi(xv[1]);
            a[4] += w1[0] * bf_lo(xv[2]); a[5] += w1[1] * bf_hi(xv[2]); a[6] += w1[2] * bf_lo(xv[3]); a[7] += w1[3] * bf_hi(xv[3]);
        }
#pragma unroll
        for (int e = 0; e < 8; ++e) a[e] = silu_f(a[e]);
        *(u32x4*)(xact + (size_t)row * 1024 + c8) = (u32x4){pack_bf16(a[0], a[1]), pack_bf16(a[2], a[3]), pack_bf16(a[4], a[5]), pack_bf16(a[6], a[7])};
    }
    const int total2 = NTOK * 16;
    for (int idx = blockIdx.x * 256 + threadIdx.x; idx < total2; idx += gridDim.x * 256) {
        const int dh = idx & 15;
        const float xr = p.dt_raw[idx] + p.dt_bias[dh];
        const float dt = xr > 20.f ? xr : log1pf(__expf(xr));
        p.dtv[idx] = dt;
        p.la[idx] = -dt * __expf(p.a_log[dh]);
    }
}

constexpr int LDV = 136;
struct ScanItem { int b, n, hh, h, rowb; bool isret; };
__device__ __forceinline__ ScanItem scan_item(int item) {
    ScanItem s; s.hh = item / (NBATCH * NCHUNK); const int bn = item % (NBATCH * NCHUNK); s.n = bn % NCHUNK; s.b = bn / NCHUNK;
    s.isret = s.hh < 8; s.h = s.hh & 7;
    s.rowb = s.n < 2 ? s.b * CTXL + s.n * 128 : NCTX + s.b * SEQL + (s.n - 2) * 128;
    return s;
}
__device__ __forceinline__ float log_sigmoid_f(float x) { return fminf(x, 0.f) - log1pf(__expf(-fabsf(x))); }
__device__ __forceinline__ void scan_cums(const Params& p, const ScanItem& s, float* cumf, float* cumb, float* vsf, float* vsb, float* xch) {
    const int t = threadIdx.x, lane = t & 63, w = t >> 6;
    const int dir = t >> 7, tt = t & 127;
    const int j = dir == 0 ? tt : 127 - tt;
    float la, vs;
    if (s.isret) { la = log_sigmoid_f(p.decay_logit[dir * 8 + s.h]); vs = 1.0f; }
    else { la = p.la[(size_t)(s.rowb + j) * 16 + dir * 8 + s.h]; vs = p.dtv[(size_t)(s.rowb + j) * 16 + dir * 8 + s.h]; }
    float v = la;
#pragma unroll
    for (int o = 1; o < 64; o <<= 1) { const float u = __shfl_up(v, o); if (lane >= o) v += u; }
    if (lane == 63) xch[w] = v;
    __syncthreads();
    if (w & 1) v += xch[w - 1];
    if (dir == 0) { cumf[j] = v; vsf[j] = vs; } else { cumb[j] = v; vsb[j] = vs; }
    __syncthreads();
}

__device__ __forceinline__ void scan_state_phase(const Params& p, char* smem) {
    bf16_t* Vtf = (bf16_t*)smem;
    bf16_t* Vtb = Vtf + 64 * LDV;
    bf16_t* Kt = Vtb + 64 * LDV;
    float* cumf = (float*)(Kt + 64 * LDV);
    float* cumb = cumf + 128; float* vsf = cumb + 128; float* vsb = vsf + 128; float* wf = vsb + 128; float* wb = wf + 128; float* xch = wb + 128;
    const int t = threadIdx.x, lane = t & 63, w = t >> 6, l31 = lane & 31, lh = lane >> 5;
    for (int item = blockIdx.x; item < NITEM; item += gridDim.x) {
        const ScanItem s = scan_item(item);
        scan_cums(p, s, cumf, cumb, vsf, vsb, xch);
        if (t < 128) wf[t] = __expf(cumf[127] - cumf[t]) * vsf[t]; else wb[t - 128] = __expf(cumb[0] - cumb[t - 128]) * vsb[t - 128];
        if (t == 0) { p.tot[item * 2 + 0] = __expf(cumf[127]); p.tot[item * 2 + 1] = __expf(cumb[0]); }
        __syncthreads();
        const bf16_t* vsrc; int ldv_; const bf16_t* ksrc; int ldk_; int dk;
        if (s.isret) { vsrc = p.big + (size_t)s.rowb * P0W + 1024 + s.h * 64; ldv_ = P0W; ksrc = p.big + (size_t)s.rowb * P0W + 512 + s.h * 64; ldk_ = P0W; dk = 64; }
        else { vsrc = p.abuf + (size_t)s.rowb * 1024 + s.h * 64; ldv_ = 1024; ksrc = p.abuf + (size_t)s.rowb * 1024 + 512 + (s.h >> 2) * 128; ldk_ = 1024; dk = 128; }
#pragma unroll
        for (int i = 0; i < 2; ++i) {
            const int u = t + 256 * i, jp = u >> 3, vc = (u & 7) * 8;
            const u32x4 xa = *(const u32x4*)(vsrc + (size_t)(2 * jp) * ldv_ + vc), xb = *(const u32x4*)(vsrc + (size_t)(2 * jp + 1) * ldv_ + vc);
            const float fa = wf[2 * jp], fb = wf[2 * jp + 1], ba = wb[2 * jp], bbv = wb[2 * jp + 1];
#pragma unroll
            for (int e = 0; e < 4; ++e) {
                const float loa = bf_lo(xa[e]), hia = bf_hi(xa[e]), lob = bf_lo(xb[e]), hib = bf_hi(xb[e]);
                *(unsigned*)(Vtf + (vc + 2 * e) * LDV + 2 * jp) = pack_bf16(loa * fa, lob * fb);
                *(unsigned*)(Vtf + (vc + 2 * e + 1) * LDV + 2 * jp) = pack_bf16(hia * fa, hib * fb);
                *(unsigned*)(Vtb + (vc + 2 * e) * LDV + 2 * jp) = pack_bf16(loa * ba, lob * bbv);
                *(unsigned*)(Vtb + (vc + 2 * e + 1) * LDV + 2 * jp) = pack_bf16(hia * ba, hib * bbv);
            }
        }
        bf16_t* stbase = s.isret ? p.st_ret + ((size_t)((s.b * NCHUNK + s.n) * 8 + s.h) * 2) * 4096
                                 : p.st_ssd + ((size_t)((s.b * NCHUNK + s.n) * 8 + s.h) * 2) * 8192;
        for (int dh = 0; dh < dk / 64; ++dh) {
#pragma unroll
            for (int i = 0; i < 2; ++i) {
                const int u = t + 256 * i, jp = u >> 3, dc = (u & 7) * 8;
                const u32x4 xa = *(const u32x4*)(ksrc + (size_t)(2 * jp) * ldk_ + dh * 64 + dc), xb = *(const u32x4*)(ksrc + (size_t)(2 * jp + 1) * ldk_ + dh * 64 + dc);
#pragma unroll
                for (int e = 0; e < 4; ++e) {
                    *(unsigned*)(Kt + (dc + 2 * e) * LDV + 2 * jp) = (xa[e] & 0xffffu) | (xb[e] << 16);
                    *(unsigned*)(Kt + (dc + 2 * e + 1) * LDV + 2 * jp) = (xa[e] >> 16) | (xb[e] & 0xffff0000u);
                }
            }
            __syncthreads();
            const int dir = w >> 1, vt = w & 1;
            const bf16_t* Vw = dir ? Vtb : Vtf;
            bf16_t* st = stbase + (size_t)dir * 64 * dk;
#pragma unroll
            for (int dt = 0; dt < 2; ++dt) {
                f32x16 acc;
#pragma unroll
                for (int r = 0; r < 16; ++r) acc[r] = 0.f;
#pragma unroll
                for (int st8 = 0; st8 < 8; ++st8) {
                    const bf16x8 a = *(const bf16x8*)(Kt + (dt * 32 + l31) * LDV + st8 * 16 + lh * 8);
                    const bf16x8 bq = *(const bf16x8*)(Vw + (vt * 32 + l31) * LDV + st8 * 16 + lh * 8);
                    acc = mfma32(a, bq, acc);
                }
#pragma unroll
                for (int g2 = 0; g2 < 2; ++g2) {
                    const int ga = 2 * g2, gb = 2 * g2 + 1;
                    const u32x2 a = {pack_bf16(acc[4 * ga], acc[4 * ga + 1]), pack_bf16(acc[4 * ga + 2], acc[4 * ga + 3])};
                    const u32x2 bq = {pack_bf16(acc[4 * gb], acc[4 * gb + 1]), pack_bf16(acc[4 * gb + 2], acc[4 * gb + 3])};
                    *(u32x4*)(st + (size_t)(vt * 32 + l31) * dk + dh * 64 + dt * 32 + 16 * g2 + 8 * lh) = swap_pair16(a, bq);
                }
            }
            __syncthreads();
        }
    }
}

__device__ __forceinline__ void scan_pass_phase(const Params& p) {
    const int total = NBATCH * 2 * 12288;
    for (int gid = blockIdx.x * 256 + threadIdx.x; gid < total; gid += gridDim.x * 256) {
        const int bd = gid / 12288, e = gid % 12288;
        const int b = bd >> 1, dir = bd & 1;
        bf16_t* base; int E, h, e8, hh;
        if (e < 4096) { h = e >> 9; e8 = (e & 511) * 8; E = 4096; base = p.st_ret; hh = h; }
        else { const int e2 = e - 4096; h = e2 >> 10; e8 = (e2 & 1023) * 8; E = 8192; base = p.st_ssd; hh = 8 + h; }
        float S[8];
#pragma unroll
        for (int i = 0; i < 8; ++i) S[i] = 0.f;
        for (int step = 0; step < NCHUNK; ++step) {
            const int n = dir == 0 ? step : (step == 0 ? 1 : (step == 1 ? 0 : 35 - step));
            bf16_t* ptr = base + ((size_t)((b * NCHUNK + n) * 8 + h) * 2 + dir) * E + e8;
            const u32x4 kv = *(const u32x4*)ptr;
            const float tt = p.tot[(hh * (NBATCH * NCHUNK) + b * NCHUNK + n) * 2 + dir];
            *(u32x4*)ptr = (u32x4){pack_bf16(S[0], S[1]), pack_bf16(S[2], S[3]), pack_bf16(S[4], S[5]), pack_bf16(S[6], S[7])};
#pragma unroll
            for (int i = 0; i < 4; ++i) { S[2 * i] = tt * S[2 * i] + bf_lo(kv[i]); S[2 * i + 1] = tt * S[2 * i + 1] + bf_hi(kv[i]); }
        }
    }
}

template <int DK>
__device__ __forceinline__ void scan_out_item(const Params& p, const ScanItem& s, bf16_t* Vt, const float* cumf, const float* cumb, const float* vsf, const float* vsb) {
    const int t = threadIdx.x, lane = t & 63, w = t >> 6, l31 = lane & 31, lh = lane >> 5;
    constexpr int NS = DK / 16;
    const bf16_t* qsrc; const bf16_t* ksrc; int ld;
    if (DK == 64) { qsrc = p.big + (size_t)s.rowb * P0W + s.h * 64; ksrc = qsrc + 512; ld = P0W; }
    else { ksrc = p.abuf + (size_t)s.rowb * 1024 + 512 + (s.h >> 2) * 128; qsrc = ksrc + 256; ld = 1024; }
    const int iq = w * 32 + l31;
    bf16x8 qf[NS];
#pragma unroll
    for (int st = 0; st < NS; ++st) qf[st] = *(const bf16x8*)(qsrc + (size_t)iq * ld + st * 16 + lh * 8);
    f32x16 O[2];
#pragma unroll
    for (int r = 0; r < 16; ++r) { O[0][r] = 0.f; O[1][r] = 0.f; }
    const float cif = cumf[iq], cib = cumb[iq];
#pragma unroll 1
    for (int kt = 0; kt < 4; ++kt) {
        f32x16 sT;
#pragma unroll
        for (int r = 0; r < 16; ++r) sT[r] = 0.f;
#pragma unroll
        for (int st = 0; st < NS; ++st) {
            const bf16x8 kf = *(const bf16x8*)(ksrc + (size_t)(kt * 32 + l31) * ld + st * 16 + lh * 8);
            sT = mfma32(kf, qf[st], sT);
        }
        const int wu = __builtin_amdgcn_readfirstlane(w);
        if (kt < wu) {
#pragma unroll
            for (int r = 0; r < 16; ++r) { const int j = kt * 32 + crow(r, lh); sT[r] *= __expf(cif - cumf[j]) * vsf[j]; }
        } else if (kt > wu) {
#pragma unroll
            for (int r = 0; r < 16; ++r) { const int j = kt * 32 + crow(r, lh); sT[r] *= __expf(cib - cumb[j]) * vsb[j]; }
        } else {
#pragma unroll
            for (int r = 0; r < 16; ++r) {
                const int j = kt * 32 + crow(r, lh);
                const float dec = (j <= iq) ? __expf(cif - cumf[j]) * vsf[j] : __expf(cib - cumb[j]) * vsb[j];
                sT[r] *= dec;
            }
        }
#pragma unroll
        for (int ts = 0; ts < 2; ++ts) {
            const u32x4 pk = {pack_bf16(sT[8 * ts + 0], sT[8 * ts + 1]), pack_bf16(sT[8 * ts + 2], sT[8 * ts + 3]), pack_bf16(sT[8 * ts + 4], sT[8 * ts + 5]), pack_bf16(sT[8 * ts + 6], sT[8 * ts + 7])};
            const bf16x8 pb = as_bf16x8(pk);
#pragma unroll
            for (int vt = 0; vt < 2; ++vt) {
                const bf16_t* vp = Vt + (vt * 32 + l31) * LDV + kt * 32 + 16 * ts + 4 * lh;
                const u32x2 v0 = *(const u32x2*)vp, v1 = *(const u32x2*)(vp + 8);
                O[vt] = mfma32(as_bf16x8((u32x4){v0[0], v0[1], v1[0], v1[1]}), pb, O[vt]);
            }
        }
    }
    const bf16_t* stb = (DK == 64) ? p.st_ret + ((size_t)((s.b * NCHUNK + s.n) * 8 + s.h) * 2) * 4096
                                   : p.st_ssd + ((size_t)((s.b * NCHUNK + s.n) * 8 + s.h) * 2) * 8192;
#pragma unroll
    for (int dir = 0; dir < 2; ++dir) {
        const float ee = __expf(dir == 0 ? cif : cib);
#pragma unroll
        for (int vt = 0; vt < 2; ++vt) {
            f32x16 T;
#pragma unroll
            for (int r = 0; r < 16; ++r) T[r] = 0.f;
#pragma unroll
            for (int st = 0; st < NS; ++st) {
                const bf16x8 sa = *(const bf16x8*)(stb + (size_t)dir * 64 * DK + (size_t)(vt * 32 + l31) * DK + st * 16 + lh * 8);
                T = mfma32(sa, qf[st], T);
            }
#pragma unroll
            for (int r = 0; r < 16; ++r) O[vt][r] += ee * T[r];
        }
    }
    const int row = s.rowb + iq;
    if (DK == 64) {
        float sm = 0.f;
#pragma unroll
        for (int r = 0; r < 16; ++r) sm += O[0][r] + O[1][r];
        sm += __shfl_xor(sm, 32);
        const float mu = sm * (1.0f / 64.0f);
        float vr = 0.f;
#pragma unroll
        for (int r = 0; r < 16; ++r) { const float d0 = O[0][r] - mu, d1 = O[1][r] - mu; vr += d0 * d0 + d1 * d1; }
        vr += __shfl_xor(vr, 32);
        const float rstd = rsqrtf(vr * (1.0f / 64.0f) + EPS);
        bf16_t* gp = p.big + (size_t)row * P0W + 2048 + s.h * 64;
#pragma unroll
        for (int vt = 0; vt < 2; ++vt) {
            u32x2 gv[4]; f32x4 gw[4];
#pragma unroll
            for (int g2 = 0; g2 < 2; ++g2) unswap_pair16(*(const u32x4*)(gp + vt * 32 + 16 * g2 + 8 * lh), gv[2 * g2], gv[2 * g2 + 1]);
#pragma unroll
            for (int g4 = 0; g4 < 4; ++g4) gw[g4] = *(const f32x4*)(p.gn_w + s.h * 64 + vt * 32 + 8 * g4 + 4 * lh);
            u32x2 ov[4];
#pragma unroll
            for (int g4 = 0; g4 < 4; ++g4) {
                const float y0 = (O[vt][4 * g4 + 0] - mu) * rstd * gw[g4][0] * silu_f(bf_lo(gv[g4][0]));
                const float y1 = (O[vt][4 * g4 + 1] - mu) * rstd * gw[g4][1] * silu_f(bf_hi(gv[g4][0]));
                const float y2 = (O[vt][4 * g4 + 2] - mu) * rstd * gw[g4][2] * silu_f(bf_lo(gv[g4][1]));
                const float y3 = (O[vt][4 * g4 + 3] - mu) * rstd * gw[g4][3] * silu_f(bf_hi(gv[g4][1]));
                ov[g4] = (u32x2){pack_bf16(y0, y1), pack_bf16(y2, y3)};
            }
#pragma unroll
            for (int g2 = 0; g2 < 2; ++g2) *(u32x4*)(gp + vt * 32 + 16 * g2 + 8 * lh) = swap_pair16(ov[2 * g2], ov[2 * g2 + 1]);
        }
    } else {
        const float dsk = p.ssd_d[s.h];
        bf16_t* zp = p.big + (size_t)row * P0W + 1536 + s.h * 64;
        const bf16_t* xp = p.abuf + (size_t)row * 1024 + s.h * 64;
        u32x2 zv[2][4], xv[2][4];
#pragma unroll
        for (int vt = 0; vt < 2; ++vt)
#pragma unroll
            for (int g2 = 0; g2 < 2; ++g2) {
                unswap_pair16(*(const u32x4*)(zp + vt * 32 + 16 * g2 + 8 * lh), zv[vt][2 * g2], zv[vt][2 * g2 + 1]);
                unswap_pair16(*(const u32x4*)(xp + vt * 32 + 16 * g2 + 8 * lh), xv[vt][2 * g2], xv[vt][2 * g2 + 1]);
            }
        u32x2 ov[2][4];
#pragma unroll
        for (int vt = 0; vt < 2; ++vt)
#pragma unroll
            for (int g4 = 0; g4 < 4; ++g4) {
                const float y0 = (O[vt][4 * g4 + 0] + dsk * bf_lo(xv[vt][g4][0])) * silu_f(bf_lo(zv[vt][g4][0]));
                const float y1 = (O[vt][4 * g4 + 1] + dsk * bf_hi(xv[vt][g4][0])) * silu_f(bf_hi(zv[vt][g4][0]));
                const float y2 = (O[vt][4 * g4 + 2] + dsk * bf_lo(xv[vt][g4][1])) * silu_f(bf_lo(zv[vt][g4][1]));
                const float y3 = (O[vt][4 * g4 + 3] + dsk * bf_hi(xv[vt][g4][1])) * silu_f(bf_hi(zv[vt][g4][1]));
                ov[vt][g4] = (u32x2){pack_bf16(y0, y1), pack_bf16(y2, y3)};
            }
#pragma unroll
        for (int vt = 0; vt < 2; ++vt)
#pragma unroll
            for (int g2 = 0; g2 < 2; ++g2) *(u32x4*)(zp + vt * 32 + 16 * g2 + 8 * lh) = swap_pair16(ov[vt][2 * g2], ov[vt][2 * g2 + 1]);
    }
}

__device__ __forceinline__ void scan_out_phase(const Params& p, char* smem) {
    bf16_t* Vt = (bf16_t*)smem;
    float* cumf = (float*)(Vt + 64 * LDV);
    float* cumb = cumf + 128; float* vsf = cumb + 128; float* vsb = vsf + 128; float* xch = vsb + 128;
    const int t = threadIdx.x;
    for (int item = blockIdx.x; item < NITEM; item += gridDim.x) {
        const ScanItem s = scan_item(item);
        scan_cums(p, s, cumf, cumb, vsf, vsb, xch);
        const bf16_t* vsrc; int ldv_;
        if (s.isret) { vsrc = p.big + (size_t)s.rowb * P0W + 1024 + s.h * 64; ldv_ = P0W; }
        else { vsrc = p.abuf + (size_t)s.rowb * 1024 + s.h * 64; ldv_ = 1024; }
#pragma unroll
        for (int i = 0; i < 2; ++i) {
            const int u = t + 256 * i, jp = u >> 3, vc = (u & 7) * 8;
            const u32x4 xa = *(const u32x4*)(vsrc + (size_t)(2 * jp) * ldv_ + vc), xb = *(const u32x4*)(vsrc + (size_t)(2 * jp + 1) * ldv_ + vc);
#pragma unroll
            for (int e = 0; e < 4; ++e) {
                *(unsigned*)(Vt + (vc + 2 * e) * LDV + 2 * jp) = (xa[e] & 0xffffu) | (xb[e] << 16);
                *(unsigned*)(Vt + (vc + 2 * e + 1) * LDV + 2 * jp) = (xa[e] >> 16) | (xb[e] & 0xffff0000u);
            }
        }
        __syncthreads();
        if (s.isret) scan_out_item<64>(p, s, Vt, cumf, cumb, vsf, vsb);
        else scan_out_item<128>(p, s, Vt, cumf, cumb, vsf, vsb);
        __syncthreads();
    }
}

constexpr int LDK = 104, LDVT = 72, KT = 64;
__device__ __forceinline__ void attn_phase(const Params& p, const bf16_t* qbuf, const bf16_t* knope, const bf16_t* vtg, bf16_t* obuf, char* smem) {
    bf16_t* Lb = (bf16_t*)smem;
    constexpr int KVB = KT * LDK + 64 * LDVT;
    const int t = threadIdx.x, lane = t & 63, w = __builtin_amdgcn_readfirstlane(t >> 6), l31 = lane & 31, lh = lane >> 5;
    const int xj = blockIdx.x >> 3, ppr = (gridDim.x >> 3) >> 4;
    for (int k = 0; ppr > 0; ++k) {
        const int pi = (blockIdx.x & 7) + 8 * (k * ppr + (xj >> 4));
        if (pi >= NBATCH * 16 || (xj >> 4) >= ppr) break;
        const int qb = xj & 15, hd = pi & 15, b = pi >> 4;
        const int m0 = b * SEQL + qb * 256 + w * 64 + l31;
        bf16x8 qf[2][6];
#pragma unroll
        for (int qt = 0; qt < 2; ++qt)
#pragma unroll
            for (int st = 0; st < 6; ++st) qf[qt][st] = *(const bf16x8*)(qbuf + (size_t)(m0 + 32 * qt) * 1536 + hd * 96 + st * 16 + lh * 8);
        f32x16 O[2][2];
#pragma unroll
        for (int r = 0; r < 16; ++r) { O[0][0][r] = 0.f; O[0][1][r] = 0.f; O[1][0][r] = 0.f; O[1][1][r] = 0.f; }
        float mrun[2] = {-1e30f, -1e30f}, lsum[2] = {0.f, 0.f};
        u32x4 rk[3], rv[2];
        const bf16_t* vbase = vtg + (size_t)(b * 16 + hd) * 64 * NKEY;
        const int kn_off0 = (t >> 3) * 1024 + (t & 7) * 8, kn_off1 = kn_off0 + 32 * 1024;
        const int kp_off = (t >> 2) * 32 + (t & 3) * 8;
        const int v_off0 = (t >> 3) * NKEY + (t & 7) * 8, v_off1 = v_off0 + 32 * NKEY;
        const int kn_lds0 = (t >> 3) * LDK + (t & 7) * 8, kn_lds1 = kn_lds0 + 32 * LDK, kp_lds = (t >> 2) * LDK + 64 + (t & 3) * 8;
        const int v_lds0 = (t >> 3) * LDVT + (t & 7) * 8, v_lds1 = v_lds0 + 32 * LDVT;
        auto gload = [&](int tile) {
            const int k0 = tile * KT;
            const int rowk0 = k0 < CTXL ? b * CTXL + k0 : NCTX + b * SEQL + (k0 - CTXL);
            const bf16_t* knb = knope + (size_t)rowk0 * 1024 + hd * 64;
            const bf16_t* kpb = p.kpe + (size_t)rowk0 * 32;
            const bf16_t* vb = vbase + k0;
            rk[0] = *(const u32x4*)(knb + kn_off0); rk[1] = *(const u32x4*)(knb + kn_off1); rk[2] = *(const u32x4*)(kpb + kp_off);
            rv[0] = *(const u32x4*)(vb + v_off0); rv[1] = *(const u32x4*)(vb + v_off1);
        };
        auto lwrite = [&](int buf) {
            bf16_t* Kb = Lb + buf * KVB; bf16_t* Vb = Kb + KT * LDK;
            *(u32x4*)(Kb + kn_lds0) = rk[0]; *(u32x4*)(Kb + kn_lds1) = rk[1]; *(u32x4*)(Kb + kp_lds) = rk[2];
            *(u32x4*)(Vb + v_lds0) = rv[0]; *(u32x4*)(Vb + v_lds1) = rv[1];
        };
        gload(0); lwrite(0); gload(1);
        constexpr int NT = NKEY / KT;
        for (int tile = 0; tile < NT; ++tile) {
            __syncthreads();
            if (tile + 1 < NT) { lwrite((tile + 1) & 1); if (tile + 2 < NT) gload(tile + 2); }
            const bf16_t* Ksm = Lb + (tile & 1) * KVB;
            const bf16_t* Vsm = Ksm + KT * LDK;
#pragma unroll
            for (int ks = 0; ks < 2; ++ks) {
                f32x16 sT[2];
#pragma unroll
                for (int r = 0; r < 16; ++r) { sT[0][r] = 0.f; sT[1][r] = 0.f; }
#pragma unroll
                for (int st = 0; st < 6; ++st) {
                    const bf16x8 kf = *(const bf16x8*)(Ksm + (ks * 32 + l31) * LDK + st * 16 + lh * 8);
                    sT[0] = mfma32(kf, qf[0][st], sT[0]);
                    sT[1] = mfma32(kf, qf[1][st], sT[1]);
                }
                u32x4 pbq[2][2];
#pragma unroll
                for (int qt = 0; qt < 2; ++qt) {
                    float mx = sT[qt][0];
#pragma unroll
                    for (int r = 1; r < 16; ++r) mx = fmaxf(mx, sT[qt][r]);
                    if (__builtin_amdgcn_ballot_w64(mx > mrun[qt] + 8.0f) != 0ull) {
                        mx = fmaxf(mx, __shfl_xor(mx, 32));
                        const float mnew = fmaxf(mrun[qt], mx);
                        const float alpha = __builtin_amdgcn_exp2f(mrun[qt] - mnew);
                        mrun[qt] = mnew;
                        lsum[qt] *= alpha;
#pragma unroll
                        for (int r = 0; r < 16; ++r) { O[qt][0][r] *= alpha; O[qt][1][r] *= alpha; }
                    }
                    float ls4[4] = {0.f, 0.f, 0.f, 0.f};
#pragma unroll
                    for (int r = 0; r < 16; ++r) {
                        const float pe = __builtin_amdgcn_exp2f(sT[qt][r] - mrun[qt]);
                        sT[qt][r] = pe;
                        ls4[r & 3] += pe;
                    }
                    lsum[qt] += (ls4[0] + ls4[1]) + (ls4[2] + ls4[3]);
#pragma unroll
                    for (int ts = 0; ts < 2; ++ts)
                        pbq[qt][ts] = (u32x4){pack_bf16(sT[qt][8 * ts + 0], sT[qt][8 * ts + 1]), pack_bf16(sT[qt][8 * ts + 2], sT[qt][8 * ts + 3]),
                                              pack_bf16(sT[qt][8 * ts + 4], sT[qt][8 * ts + 5]), pack_bf16(sT[qt][8 * ts + 6], sT[qt][8 * ts + 7])};
                }
#pragma unroll
                for (int ts = 0; ts < 2; ++ts)
#pragma unroll
                    for (int vt = 0; vt < 2; ++vt) {
                        const bf16_t* vp = Vsm + (vt * 32 + l31) * LDVT + ks * 32 + 16 * ts + 4 * lh;
                        const u32x2 v0 = *(const u32x2*)vp, v1 = *(const u32x2*)(vp + 8);
                        const bf16x8 va = as_bf16x8((u32x4){v0[0], v0[1], v1[0], v1[1]});
                        O[0][vt] = mfma32(va, as_bf16x8(pbq[0][ts]), O[0][vt]);
                        O[1][vt] = mfma32(va, as_bf16x8(pbq[1][ts]), O[1][vt]);
                    }
            }
        }
#pragma unroll
        for (int qt = 0; qt < 2; ++qt) {
            const float lt = lsum[qt] + __shfl_xor(lsum[qt], 32);
            const float inv = 1.0f / lt;
            bf16_t* op = obuf + (size_t)(m0 + 32 * qt) * 1024 + hd * 64;
#pragma unroll
            for (int vt = 0; vt < 2; ++vt)
#pragma unroll
                for (int g2 = 0; g2 < 2; ++g2) {
                    const int ga = 2 * g2, gb = 2 * g2 + 1;
                    const u32x2 a = {pack_bf16(O[qt][vt][4 * ga] * inv, O[qt][vt][4 * ga + 1] * inv), pack_bf16(O[qt][vt][4 * ga + 2] * inv, O[qt][vt][4 * ga + 3] * inv)};
                    const u32x2 b = {pack_bf16(O[qt][vt][4 * gb] * inv, O[qt][vt][4 * gb + 1] * inv), pack_bf16(O[qt][vt][4 * gb + 2] * inv, O[qt][vt][4 * gb + 3] * inv)};
                    *(u32x4*)(op + vt * 32 + 16 * g2 + 8 * lh) = swap_pair16(a, b);
                }
        }
        __syncthreads();
    }
}

__device__ __forceinline__ void run_phase(const Params& p, int ph, char* smem) {
    bf16_t* cqkv = p.big;
    bf16_t* qbuf = p.big + (size_t)NTOK * CQW;
    bf16_t* knope = qbuf + (size_t)NLAT * 1536;
    bf16_t* obuf = p.big;
    bf16_t* hmid = p.big;
    switch (ph) {
    case 0: if ((PHASE_MASK >> 0) & 1) {
        const int total = 384 + WC0_TILES + 1;
        for (int it = blockIdx.x; it < total; it += gridDim.x) {
            if (it < 384) adaln_item(p, it, smem);
            else if (it < 384 + WC0_TILES) wconv_item(p, 0, it - 384, smem);
            else rope_item(p);
        }
    } break;
    case 1: if ((PHASE_MASK >> 1) & 1) norm_mod_phase(p, 0, 0, 0, 0, NTOK); break;
    case 2: if ((PHASE_MASK >> 2) & 1) { GemmDesc g{p.abuf, DM, p.wt_in0, 1024, 0}; EpiProj0 e{p.big, p.dt_raw, p.rope_ret}; gemm_phase<4, false>(g, NTOK / 256, 29, e, smem); } break;
    case 3: if ((PHASE_MASK >> 3) & 1) conv_phase(p); break;
    case 4: if ((PHASE_MASK >> 4) & 1) scan_state_phase(p, smem); break;
    case 5: if ((PHASE_MASK >> 5) & 1) scan_pass_phase(p); break;
    case 6: if ((PHASE_MASK >> 6) & 1) scan_out_phase(p, smem); break;
    case 7: if ((PHASE_MASK >> 7) & 1) { GemmDesc g{p.big + 1536, P0W, p.wt_out0, 1024, 512}; EpiResid e{p.ctx, p.x, p.hctx, p.out, p.ada + 2 * 1024, 0}; GemmDesc gl = g; gl.A = g.A + (size_t)NCTX * P0W; EpiResid el = e; el.row_off = NCTX;
        TileOrder ord; ord.init(NLAT / 256, 8);
        int tm, tn;
        for (int k = 0; ord.get(k, tm, tn); ++k) gemm_tile<4, true>(gl, tm, tn, el, smem);
        for (int it = blockIdx.x; it < (NCTX / 128) * 8; it += gridDim.x) gemm_tile<2, true>(g, it / 8, it % 8, e, smem);
        } break;
    case 8: if ((PHASE_MASK >> 8) & 1) {
        norm_mod_phase(p, 1, 0, 3, 0, NTOK);
        for (int it = blockIdx.x; it < WC1_TILES; it += gridDim.x) wconv_item(p, 1, it, smem);
    } break;
    case 9: if ((PHASE_MASK >> 9) & 1) { GemmDesc g{p.abuf, DM, p.wt_f1_0, 1024, 0}; EpiSwiglu e{hmid}; gemm_phase<4, false>(g, NTOK / 256, 44, e, smem); } break;
    case 10: if ((PHASE_MASK >> 10) & 1) { GemmDesc g{hmid, DFF, p.wt_f2_0, DFF, 0}; EpiResid e{p.hctx, p.out, p.hctx, p.out, p.ada + 5 * 1024, 0};
        const int tc = (NCTX / 128) * 8 * 4;
        GemmDesc gl = g; gl.A = g.A + (size_t)NCTX * DFF; EpiResid el = e; el.row_off = NCTX;
        EpiResidAtomic ea{p.hctx, p.ada + 5 * 1024};
        {
            TileOrder ord; ord.init(NLAT / 256, 8);
            int tm, tn;
            for (int k = 0; ord.get(k, tm, tn); ++k) gemm_tile<4, false>(gl, tm, tn, el, smem);
        }
        for (int c = blockIdx.x; c < tc; c += gridDim.x) {
            const int tile = c >> 2, ks = c & 3;
            GemmDesc gc = g; gc.A = g.A + ks * (DFF / 4); gc.Bt = g.Bt + ks * (DFF / 4); gc.klen = DFF / 4;
            gemm_tile<2, false>(gc, tile / 8, tile % 8, ea, smem);
        } } break;
    case 11: if ((PHASE_MASK >> 11) & 1) norm_mod_phase(p, 1, 1, 0, 0, NTOK); break;
    case 12: if ((PHASE_MASK >> 12) & 1) { GemmDesc g{p.abuf, DM, p.wt_mla_in, 1024, 0}; EpiCqkv e{cqkv, p.kpe, p.rope_mla}; gemm_phase_tail2(g, NTOK / 256, 9, e, smem); } break;
    case 13: if ((PHASE_MASK >> 13) & 1) {
        GemmDesc gq{cqkv + (size_t)NCTX * CQW, CQW, p.wt_uq, 768, 768}; EpiQ eq{qbuf, p.rope_mla};
        GemmDesc gk{cqkv + 768, CQW, p.wt_ukv, 256, 256}; EpiKV ek{knope, p.abuf};
        const int t1 = (NLAT / 256) * 12, t2 = (NTOK / 256) * 16;
        for (int it = blockIdx.x; it < t1 + t2; it += gridDim.x) {
            if (it < t1) gemm_tile<4, true>(gq, it / 12, it % 12, eq, smem);
            else { const int i2 = it - t1; gemm_tile<4, true>(gk, i2 / 16, i2 % 16, ek, smem); }
        }
    } break;
    case 14: if ((PHASE_MASK >> 14) & 1) attn_phase(p, qbuf, knope, p.abuf, obuf, smem); break;
    case 15: if ((PHASE_MASK >> 15) & 1) { GemmDesc g{obuf, DM, p.wt_mla_out, 1024, 0}; EpiResid e{p.hctx, p.out, p.hctx, p.out, p.ada + (size_t)5 * 6144 + 2 * 1024, NCTX}; gemm_phase<4, false>(g, NLAT / 256, 8, e, smem); } break;
    case 16: if ((PHASE_MASK >> 16) & 1) norm_mod_phase(p, 1, 1, 3, NCTX, NTOK); break;
    case 17: if ((PHASE_MASK >> 17) & 1) { GemmDesc g{p.abuf + (size_t)NCTX * DM, DM, p.wt_f1_1, 1024, 0}; EpiSwiglu e{hmid}; gemm_phase_tail2(g, NLAT / 256, 44, e, smem); } break;
    case 18: if ((PHASE_MASK >> 18) & 1) { GemmDesc g{hmid, DFF, p.wt_f2_1, DFF, 0}; EpiResid e{p.hctx, p.out, p.hctx, p.out, p.ada + (size_t)5 * 6144 + 5 * 1024, NCTX}; gemm_phase<4, false>(g, NLAT / 256, 8, e, smem); } break;
    case 19: if ((PHASE_MASK >> 19) & 1) final_norm_phase(p); break;
    default: break;
    }
}

constexpr int SMEM_BYTES = (256 + 128) * LDT * 2 + 256 * 4;

__global__ void __launch_bounds__(256, 2) fwd_megakernel(Params p, int ph_lo, int ph_hi) {
    __shared__ __attribute__((aligned(16))) char smem[SMEM_BYTES];
    __shared__ __attribute__((aligned(16))) unsigned xb_words[4];
    cg::grid_group grid = cg::this_grid();
    if (threadIdx.x < 4) xb_words[threadIdx.x] = 0u;
    __syncthreads();
    XcdBarrier xb = xcd_barrier_post(p.bar, xb_words);
    if (ph_hi > 1000) grid.sync();
#ifndef PROBE_DUP
#define PROBE_DUP -1
#endif
#define RUN_PH(N) if (ph_lo <= N && N < ph_hi) { if (N == PROBE_DUP) run_phase(p, N, smem); run_phase(p, N, smem); if (N + 1 < ph_hi) xcd_barrier(xb); }
    RUN_PH(0) RUN_PH(1) RUN_PH(2) RUN_PH(3) RUN_PH(4) RUN_PH(5) RUN_PH(6) RUN_PH(7) RUN_PH(8) RUN_PH(9)
    RUN_PH(10) RUN_PH(11) RUN_PH(12) RUN_PH(13) RUN_PH(14) RUN_PH(15) RUN_PH(16) RUN_PH(17) RUN_PH(18) RUN_PH(19)
#undef RUN_PH
}

extern "C" void kernel_launch(void* const* d_in, const int* in_sizes, int n_in, void* d_out, int out_size, void* d_ws, size_t ws_size, hipStream_t stream) {
    static int grid_blocks = 0;
    if (grid_blocks == 0) {
        int dev = 0, cus = 0, per_cu = 0;
        hipGetDevice(&dev);
        hipDeviceGetAttribute(&cus, hipDeviceAttributeMultiprocessorCount, dev);
        hipOccupancyMaxActiveBlocksPerMultiprocessor(&per_cu, fwd_megakernel, 256, 0);
        if (per_cu < 1) per_cu = 1;
        if (per_cu > 2) per_cu = 2;
        grid_blocks = cus * per_cu;
    }
    Params p{};
    const float* const* in = (const float* const*)d_in;
    p.x = in[0]; p.c = in[1]; p.ctx = in[2]; p.c_ctx = in[3]; p.w_ada = in[4]; p.b_ada = in[5]; p.w_gate = in[6]; p.w_up = in[7]; p.w_down = in[8];
    p.w_in0 = in[9]; p.conv_w = in[10]; p.conv_b = in[11]; p.dt_bias = in[12]; p.a_log = in[13]; p.ssd_d = in[14]; p.ssd_norm_w = in[15];
    p.decay_logit = in[16]; p.gn_w = in[17]; p.w_out0 = in[18]; p.mla_w_in = in[19]; p.q_norm_w = in[20]; p.w_uq = in[21]; p.kv_norm_w = in[22];
    p.w_ukv = in[23]; p.mla_w_out = in[24]; p.final_norm_w = in[25];
    p.out = (float*)d_out;
    char* ws = (char*)d_ws;
    size_t off = 0;
    auto take = [&](size_t bytes) { char* r = ws + off; off += (bytes + 255) & ~(size_t)255; return r; };
    p.wt_in0 = (bf16_t*)take((size_t)3712 * 1024 * 2);
    p.wt_out0 = (bf16_t*)take((size_t)1024 * 1024 * 2);
    p.wt_f1_0 = (bf16_t*)take((size_t)5632 * 1024 * 2);
    p.wt_f2_0 = (bf16_t*)take((size_t)1024 * 2816 * 2);
    p.big = (bf16_t*)take((size_t)NTOK * P0W * 2);
    p.abuf = (bf16_t*)take((size_t)NTOK * 1024 * 2);
    char* states = take((size_t)NITEM / 2 * 2 * 4096 * 2 + (size_t)NITEM / 2 * 2 * 8192 * 2);
    p.st_ret = (bf16_t*)states;
    p.st_ssd = p.st_ret + (size_t)(NITEM / 2) * 2 * 4096;
    {
        char* w1 = states; size_t o1 = 0;
        auto take1 = [&](size_t bytes) { char* r = w1 + o1; o1 += (bytes + 255) & ~(size_t)255; return r; };
        p.wt_mla_in = (bf16_t*)take1((size_t)1152 * 1024 * 2);
        p.wt_uq = (bf16_t*)take1((size_t)1536 * 768 * 2);
        p.wt_ukv = (bf16_t*)take1((size_t)2048 * 256 * 2);
        p.wt_mla_out = (bf16_t*)take1((size_t)1024 * 1024 * 2);
        p.wt_f1_1 = (bf16_t*)take1((size_t)5632 * 1024 * 2);
        p.wt_f2_1 = (bf16_t*)take1((size_t)1024 * 2816 * 2);
    }
    p.hctx = (float*)take((size_t)NCTX * DM * 4);
    p.ada = (float*)take((size_t)2 * 5 * 6144 * 4);
    p.rope_ret = (float*)take(2048 * 4);
    p.rope_mla = (float*)take(1024 * 4);
    p.dt_raw = (float*)take((size_t)NTOK * 16 * 4);
    p.dtv = (float*)take((size_t)NTOK * 16 * 4);
    p.la = (float*)take((size_t)NTOK * 16 * 4);
    p.tot = (float*)take((size_t)NITEM * 2 * 4);
    p.kpe = (bf16_t*)take((size_t)NTOK * 32 * 2);
    p.bar = (unsigned*)take((size_t)XCD_BAR_WORDS * 4);
    if (off > ws_size) { fprintf(stderr, "kernel_launch: workspace too small: need %zu, have %zu\n", off, ws_size); return; }
    for (int f = 0; f < 16; ++f) p.inv_ret[f] = powf(10000.0f, -(float)f / 16.0f);
    for (int f = 0; f < 8; ++f) p.inv_mla[f] = powf(10000.0f, -(float)f / 8.0f);
    hipMemsetAsync(p.bar, 0, (size_t)XCD_BAR_WORDS * 4, stream);
#if SINGLE_LAUNCH
    int lo = 0, hi = NPHASE;
    void* args[] = {&p, &lo, &hi};
    hipError_t e = hipLaunchCooperativeKernel((const void*)fwd_megakernel, dim3(grid_blocks), dim3(256), args, 0, stream);
    if (e != hipSuccess) fprintf(stderr, "cooperative launch failed: %s (grid %d)\n", hipGetErrorString(e), grid_blocks);
#else
    for (int ph = 0; ph < NPHASE; ++ph) hipLaunchKernelGGL(fwd_megakernel, dim3(grid_blocks), dim3(256), 0, stream, p, ph, ph + 1);
#endif
}
```

```cpp
#include <hip/hip_runtime.h>
#include <hip/hip_cooperative_groups.h>
#include <cstdio>
#include <cmath>
namespace cg = cooperative_groups;

#ifndef PHASE_MASK
#define PHASE_MASK 0xFFFFF
#endif
#ifndef SINGLE_LAUNCH
#define SINGLE_LAUNCH 1
#endif

typedef unsigned short bf16_t;
typedef short bf16x8 __attribute__((ext_vector_type(8)));
typedef float f32x16 __attribute__((ext_vector_type(16)));
typedef float f32x4 __attribute__((ext_vector_type(4)));
typedef unsigned u32x4 __attribute__((ext_vector_type(4)));
typedef unsigned u32x2 __attribute__((ext_vector_type(2)));

constexpr int DM = 1024, NBATCH = 4, SEQL = 4096, CTXL = 256;
constexpr int NCTX = NBATCH * CTXL;
constexpr int NLAT = NBATCH * SEQL;
constexpr int NTOK = NCTX + NLAT;
constexpr int DFF = 2816;
constexpr int P0W = 3584;
constexpr int CQW = 1056;
constexpr int NKEY = CTXL + SEQL;
constexpr int NCHUNK = 34;
constexpr int NITEM = NBATCH * NCHUNK * 16;
constexpr float EPS = 1e-6f;
constexpr int NPHASE = 20;

struct Params {
    const float *x, *c, *ctx, *c_ctx, *w_ada, *b_ada, *w_gate, *w_up, *w_down, *w_in0, *conv_w, *conv_b, *dt_bias, *a_log,
        *ssd_d, *ssd_norm_w, *decay_logit, *gn_w, *w_out0, *mla_w_in, *q_norm_w, *w_uq, *kv_norm_w, *w_ukv, *mla_w_out, *final_norm_w;
    float* out;
    bf16_t *wt_in0, *wt_out0, *wt_f1_0, *wt_f2_0;
    bf16_t *wt_mla_in, *wt_uq, *wt_ukv, *wt_mla_out, *wt_f1_1, *wt_f2_1;
    bf16_t *big, *abuf, *st_ret, *st_ssd, *kpe;
    float *hctx, *ada, *rope_ret, *rope_mla, *dt_raw, *dtv, *la, *tot; unsigned* bar;
    float inv_ret[16];
    float inv_mla[8];
};

typedef float f32x2 __attribute__((ext_vector_type(2)));
typedef __bf16 bf16x2_t __attribute__((ext_vector_type(2)));
__device__ __forceinline__ unsigned pack_bf16(float lo, float hi) {
    f32x2 v = {lo, hi};
    union { bf16x2_t b; unsigned u; } x; x.b = __builtin_convertvector(v, bf16x2_t); return x.u;
}
__device__ __forceinline__ bf16_t f2bf(float v) { return (bf16_t)(pack_bf16(v, 0.f) & 0xffffu); }
__device__ __forceinline__ float bf_lo(unsigned u) { return __uint_as_float(u << 16); }
__device__ __forceinline__ float bf_hi(unsigned u) { return __uint_as_float(u & 0xffff0000u); }
__device__ __forceinline__ float bf2f(bf16_t h) { return __uint_as_float(((unsigned)h) << 16); }
__device__ __forceinline__ float silu_f(float v) { return v * __builtin_amdgcn_rcpf(1.0f + __expf(-v)); }
__device__ __forceinline__ float wave_sum(float v) {
    v += __shfl_xor(v, 32); v += __shfl_xor(v, 16); v += __shfl_xor(v, 8);
    v += __shfl_xor(v, 4);  v += __shfl_xor(v, 2);  v += __shfl_xor(v, 1);
    return v;
}
__device__ __forceinline__ f32x16 mfma32(bf16x8 a, bf16x8 b, f32x16 c) { return __builtin_amdgcn_mfma_f32_32x32x16_bf16(a, b, c, 0, 0, 0); }
__device__ __forceinline__ bf16x8 as_bf16x8(u32x4 v) { union { u32x4 u; bf16x8 b; } x; x.u = v; return x.b; }
__device__ __forceinline__ int cond_of_row(int row) { return row < NCTX ? 4 : ((row - NCTX) >> 12); }
__device__ __forceinline__ int crow(int r, int lh) { return (r & 3) + 8 * (r >> 2) + 4 * lh; }


#define XB_TMO      128
#define XB_XCNT(j)  (256  + 64 * (j))
#define XB_XSUB(j)  (1280 + 64 * (j))
#define XB_XGEN(j)  (2304 + 64 * (j))
#define XB_TOP      3328
#define XB_TOPGEN   3392
#define XCD_BAR_WORDS 3456
#define XB_SPIN_CAP (1u << 22)
#define LAS __attribute__((address_space(3)))
__device__ __forceinline__ unsigned xb_ld(unsigned* p)              { return __hip_atomic_load(p, __ATOMIC_RELAXED, __HIP_MEMORY_SCOPE_AGENT); }
__device__ __forceinline__ unsigned xb_add(unsigned* p, unsigned v) { return __hip_atomic_fetch_add(p, v, __ATOMIC_RELAXED, __HIP_MEMORY_SCOPE_AGENT); }
__device__ __forceinline__ unsigned xb_xcc_id() { return (unsigned)__builtin_amdgcn_s_getreg((3 << 11) | 20) & 0xFu; }
#define XB_SPIN(cond, bar) do { unsigned _sp = 0; while (cond) { __builtin_amdgcn_s_sleep(1); \
    if ((++_sp & 255u) == 0u) { if (xb_ld(&(bar)[XB_TMO])) break; if (_sp > XB_SPIN_CAP) { atomicAdd(&(bar)[XB_TMO], 1u); break; } } } } while (0)
struct XcdBarrier { unsigned* bar; unsigned x; volatile unsigned* st; };
__device__ __forceinline__ XcdBarrier xcd_barrier_post(unsigned* bar, volatile unsigned* st) {
    XcdBarrier b; b.bar = bar; b.x = xb_xcc_id(); b.st = st;
    if (threadIdx.x == 0) (void)xb_add(&bar[XB_XCNT(b.x)], 1u);
    return b;
}
__device__ __forceinline__ void xcd_barrier_complete(unsigned* bar, unsigned x, unsigned& nloc, unsigned& nx) {
    const unsigned G = gridDim.x * gridDim.y * gridDim.z;
    unsigned sum, cnt, mine, sp = 0u;
    for (;;) {
        sum = 0u; cnt = 0u; mine = 0u;
#pragma unroll
        for (unsigned j = 0; j < 16; ++j) { const unsigned c = xb_ld(&bar[XB_XCNT(j)]); sum += c; cnt += (c > 0u) ? 1u : 0u; mine = (j == x) ? c : mine; }
        if (sum == G) break;
        __builtin_amdgcn_s_sleep(1);
        if ((++sp & 255u) == 0u) { if (xb_ld(&bar[XB_TMO])) break; if (sp > XB_SPIN_CAP) { atomicAdd(&bar[XB_TMO], 1u); break; } }
    }
    nloc = mine > 0u ? mine : 1u; nx = cnt > 0u ? cnt : 1u;
}
__device__ __forceinline__ void xcd_barrier(const XcdBarrier& b) {
    asm volatile("s_waitcnt vmcnt(0)" ::: "memory");
    __syncthreads();
    if (threadIdx.x == 0) {
        unsigned* bar = b.bar;
        __builtin_amdgcn_s_waitcnt(0);
        unsigned nloc = b.st[0], nx = b.st[1];
        if (nloc == 0u) { xcd_barrier_complete(bar, b.x, nloc, nx); b.st[0] = nloc; b.st[1] = nx; }
        const unsigned old = xb_add(&bar[XB_XSUB(b.x)], 1u);
        const unsigned gen = old / nloc;
        if (old + 1u == (gen + 1u) * nloc) {
            __builtin_amdgcn_fence(__ATOMIC_RELEASE, "agent");
            asm volatile("s_waitcnt vmcnt(0)" ::: "memory");
            const unsigned og = xb_add(&bar[XB_TOP], 1u);
            const unsigned tg = og / nx;
            if (og + 1u == (tg + 1u) * nx) xb_add(&bar[XB_TOPGEN], 1u);
            else XB_SPIN(xb_ld(&bar[XB_TOPGEN]) == tg, bar);
            __builtin_amdgcn_fence(__ATOMIC_ACQUIRE, "agent");
            xb_add(&bar[XB_XGEN(b.x)], 1u);
            asm volatile("s_waitcnt vmcnt(0)" ::: "memory");
        } else {
            XB_SPIN(xb_ld(&bar[XB_XGEN(b.x)]) == gen, bar);
            __builtin_amdgcn_fence(__ATOMIC_ACQUIRE, "agent");
            asm volatile("s_waitcnt vmcnt(0)" ::: "memory");
        }
    }
    __syncthreads();
}

struct WJob { const float* src; const float* src2; const float* kscale; bf16_t* dst; int K, Nsrc, Ndst, mode; };
__device__ __forceinline__ void wconv_tile(const WJob& j, int tk, int tn, char* smem) {
    float* sm = (float*)smem;
    const int t = threadIdx.x;
#pragma unroll
    for (int i = 0; i < 4; ++i) {
        const int kl = (t >> 4) + 16 * i, nq = (t & 15) * 4;
        const int np = tn * 64 + nq, kp = tk * 64 + kl;
        int row = kp, col = np; const float* arr = j.src; bool valid = true; float sc = 1.0f;
        if (j.mode == 0) {
            if (np >= 1536 && np < 2048) col = np + 512; else if (np >= 2048 && np < 2560) col = np - 512;
            if (np >= 3600) valid = false;
        } else if (j.mode == 1) {
            row = kp < 512 ? kp + 512 : kp - 512;
            if (kp < 512) sc = j.kscale[kp];
        } else if (j.mode == 2) {
            const int t128 = np >> 7, wn = (np >> 6) & 1, half = (np >> 5) & 1, cc = np & 31;
            col = t128 * 64 + wn * 32 + cc; arr = half ? j.src2 : j.src;
        } else {
            if (np >= j.Nsrc) valid = false;
            if (j.kscale) sc = j.kscale[kp];
        }
        f32x4 v = {0.f, 0.f, 0.f, 0.f};
        if (valid) v = __builtin_nontemporal_load((const f32x4*)(arr + (size_t)row * j.Nsrc + col));
        sm[kl * 65 + nq + 0] = v[0] * sc; sm[kl * 65 + nq + 1] = v[1] * sc; sm[kl * 65 + nq + 2] = v[2] * sc; sm[kl * 65 + nq + 3] = v[3] * sc;
    }
    __syncthreads();
    {
        const int nl = t >> 2, ks = (t & 3) * 16;
        unsigned w[8];
#pragma unroll
        for (int e = 0; e < 8; ++e) w[e] = pack_bf16(sm[(ks + 2 * e) * 65 + nl], sm[(ks + 2 * e + 1) * 65 + nl]);
        bf16_t* d = j.dst + (size_t)(tn * 64 + nl) * j.K + tk * 64 + ks;
        *(u32x4*)d = (u32x4){w[0], w[1], w[2], w[3]};
        *(u32x4*)(d + 8) = (u32x4){w[4], w[5], w[6], w[7]};
    }
    __syncthreads();
}
__device__ __forceinline__ void mk_job(WJob& j, const float* src, const float* src2, const float* ks, bf16_t* dst, int K, int Nsrc, int Ndst, int mode) {
    j.src = src; j.src2 = src2; j.kscale = ks; j.dst = dst; j.K = K; j.Nsrc = Nsrc; j.Ndst = Ndst; j.mode = mode;
}
constexpr int WC0_TILES = 928 + 256 + 1408 + 704;
constexpr int WC1_TILES = 288 + 288 + 128 + 256 + 1408 + 704;
__device__ __forceinline__ void wconv_item(const Params& p, int set, int idx, char* smem) {
    WJob j;
    if (set == 0) {
        if (idx < 928) mk_job(j, p.w_in0, nullptr, nullptr, p.wt_in0, 1024, 3600, 3712, 0);
        else if ((idx -= 928) < 256) mk_job(j, p.w_out0, nullptr, p.ssd_norm_w, p.wt_out0, 1024, 1024, 1024, 1);
        else if ((idx -= 256) < 1408) mk_job(j, p.w_gate, p.w_up, nullptr, p.wt_f1_0, 1024, 2816, 5632, 2);
        else { idx -= 1408; mk_job(j, p.w_down, nullptr, nullptr, p.wt_f2_0, 2816, 1024, 1024, 3); }
    } else {
        if (idx < 288) mk_job(j, p.mla_w_in, nullptr, nullptr, p.wt_mla_in, 1024, 1056, 1152, 3);
        else if ((idx -= 288) < 288) mk_job(j, p.w_uq, nullptr, p.q_norm_w, p.wt_uq, 768, 1536, 1536, 3);
        else if ((idx -= 288) < 128) mk_job(j, p.w_ukv, nullptr, p.kv_norm_w, p.wt_ukv, 256, 2048, 2048, 3);
        else if ((idx -= 128) < 256) mk_job(j, p.mla_w_out, nullptr, nullptr, p.wt_mla_out, 1024, 1024, 1024, 3);
        else if ((idx -= 256) < 1408) mk_job(j, p.w_gate + (size_t)1024 * 2816, p.w_up + (size_t)1024 * 2816, nullptr, p.wt_f1_1, 1024, 2816, 5632, 2);
        else { idx -= 1408; mk_job(j, p.w_down + (size_t)2816 * 1024, nullptr, nullptr, p.wt_f2_1, 2816, 1024, 1024, 3); }
    }
    const int nkt = j.K / 64;
    wconv_tile(j, idx % nkt, idx / nkt, smem);
}

__device__ __forceinline__ void adaln_item(const Params& p, int a, char* smem) {
    float* sc = (float*)smem;
    float* red = sc + 5 * 1024;
    const int t = threadIdx.x;
    const int layer = a / 192, cb = a % 192;
    for (int i = t; i < 5 * 1024; i += 256) {
        const int cnd = i >> 10, k = i & 1023;
        const float v = cnd < 4 ? p.c[cnd * 1024 + k] : p.c_ctx[k];
        sc[i] = silu_f(v);
    }
    __syncthreads();
    const int kq = t >> 3, cq = t & 7;
    const int col = cb * 32 + cq * 4;
    float acc[5][4];
#pragma unroll
    for (int cnd = 0; cnd < 5; ++cnd) { acc[cnd][0] = acc[cnd][1] = acc[cnd][2] = acc[cnd][3] = 0.f; }
    const float* wp = p.w_ada + (size_t)layer * 1024 * 6144 + col;
#pragma unroll 4
    for (int kk = 0; kk < 32; ++kk) {
        const int k = kq + 32 * kk;
        const f32x4 w = __builtin_nontemporal_load((const f32x4*)(wp + (size_t)k * 6144));
#pragma unroll
        for (int cnd = 0; cnd < 5; ++cnd) {
            const float s = sc[cnd * 1024 + k];
            acc[cnd][0] += s * w[0]; acc[cnd][1] += s * w[1]; acc[cnd][2] += s * w[2]; acc[cnd][3] += s * w[3];
        }
    }
#pragma unroll
    for (int cnd = 0; cnd < 5; ++cnd)
#pragma unroll
        for (int e = 0; e < 4; ++e) red[(kq * 8 + cq) * 20 + cnd * 4 + e] = acc[cnd][e];
    __syncthreads();
    if (t < 160) {
        const int cnd = t >> 5, cl = t & 31;
        float s = p.b_ada[layer * 6144 + cb * 32 + cl];
        for (int q = 0; q < 32; ++q) s += red[(q * 8 + (cl >> 2)) * 20 + cnd * 4 + (cl & 3)];
        p.ada[(size_t)(layer * 5 + cnd) * 6144 + cb * 32 + cl] = s;
    }
    __syncthreads();
}

__device__ __forceinline__ void sincos_acc(float xf, float& s, float& c) {
    const double x = (double)xf;
    const double k = rint(x * 0.63661977236758134308);
    const double r = x - k * 1.57079632679489661923;
    const double r2 = r * r;
    double sp = r * (1.0 + r2 * (-1.0 / 6 + r2 * (1.0 / 120 + r2 * (-1.0 / 5040 + r2 * (1.0 / 362880 + r2 * (-1.0 / 39916800 + r2 * (1.0 / 6227020800.0)))))));
    double cp = 1.0 + r2 * (-0.5 + r2 * (1.0 / 24 + r2 * (-1.0 / 720 + r2 * (1.0 / 40320 + r2 * (-1.0 / 3628800 + r2 * (1.0 / 479001600.0 + r2 * (-1.0 / 87178291200.0)))))));
    const int q = ((int)k) & 3;
    double ss, cc;
    if (q == 0) { ss = sp; cc = cp; } else if (q == 1) { ss = cp; cc = -sp; } else if (q == 2) { ss = -sp; cc = -cp; } else { ss = -cp; cc = sp; }
    s = (float)ss; c = (float)cc;
}
__device__ __forceinline__ void rope_item(const Params& p) {
    for (int i = threadIdx.x; i < 1024 + 512; i += 256) {
        float s, c;
        if (i < 1024) { const int pos = i >> 4, f = i & 15; sincos_acc((float)pos * p.inv_ret[f], s, c); p.rope_ret[i] = c; p.rope_ret[1024 + i] = s; }
        else { const int ii = i - 1024, pos = ii >> 3, f = ii & 7; sincos_acc((float)pos * p.inv_mla[f], s, c); p.rope_mla[ii] = c; p.rope_mla[512 + ii] = s; }
    }
}

__device__ __forceinline__ void norm_mod_phase(const Params& p, int src_mode, int layer, int shift_chunk, int row0, int row1) {
    const int lane = threadIdx.x & 63, w = threadIdx.x >> 6;
    for (int row = row0 + blockIdx.x * 4 + w; row < row1; row += gridDim.x * 4) {
        const float* src;
        if (row < NCTX) src = (src_mode == 0 ? p.ctx : p.hctx) + (size_t)row * DM;
        else src = (src_mode == 0 ? p.x : p.out) + (size_t)(row - NCTX) * DM;
        f32x4 v[4]; float ss = 0.f;
#pragma unroll
        for (int i = 0; i < 4; ++i) { v[i] = *(const f32x4*)(src + (lane + 64 * i) * 4); ss += v[i][0] * v[i][0] + v[i][1] * v[i][1] + v[i][2] * v[i][2] + v[i][3] * v[i][3]; }
        ss = wave_sum(ss);
        const float r = rsqrtf(ss * (1.0f / DM) + EPS);
        const float* ad = p.ada + (size_t)(layer * 5 + cond_of_row(row)) * 6144;
        const float* shp = ad + shift_chunk * 1024;
        const float* scp = ad + (shift_chunk + 1) * 1024;
        bf16_t* dst = p.abuf + (size_t)row * DM;
        f32x4 sh[4], sc[4];
#pragma unroll
        for (int i = 0; i < 4; ++i) { sh[i] = *(const f32x4*)(shp + (lane + 64 * i) * 4); sc[i] = *(const f32x4*)(scp + (lane + 64 * i) * 4); }
        u32x2 o[4];
#pragma unroll
        for (int i = 0; i < 4; ++i) {
            const float y0 = v[i][0] * r * (1.f + sc[i][0]) + sh[i][0], y1 = v[i][1] * r * (1.f + sc[i][1]) + sh[i][1];
            const float y2 = v[i][2] * r * (1.f + sc[i][2]) + sh[i][2], y3 = v[i][3] * r * (1.f + sc[i][3]) + sh[i][3];
            o[i] = (u32x2){pack_bf16(y0, y1), pack_bf16(y2, y3)};
        }
#pragma unroll
        for (int i = 0; i < 4; ++i) *(u32x2*)(dst + (lane + 64 * i) * 4) = o[i];
    }
}
__device__ __forceinline__ void final_norm_phase(const Params& p) {
    const int lane = threadIdx.x & 63, w = threadIdx.x >> 6;
    for (int row = blockIdx.x * 4 + w; row < NLAT; row += gridDim.x * 4) {
        float* src = p.out + (size_t)row * DM;
        f32x4 v[4]; float ss = 0.f;
#pragma unroll
        for (int i = 0; i < 4; ++i) { v[i] = *(const f32x4*)(src + (lane + 64 * i) * 4); ss += v[i][0] * v[i][0] + v[i][1] * v[i][1] + v[i][2] * v[i][2] + v[i][3] * v[i][3]; }
        ss = wave_sum(ss);
        const float r = rsqrtf(ss * (1.0f / DM) + EPS);
        f32x4 wv[4];
#pragma unroll
        for (int i = 0; i < 4; ++i) wv[i] = *(const f32x4*)(p.final_norm_w + (lane + 64 * i) * 4);
#pragma unroll
        for (int i = 0; i < 4; ++i) v[i] = (f32x4){v[i][0] * r * wv[i][0], v[i][1] * r * wv[i][1], v[i][2] * r * wv[i][2], v[i][3] * r * wv[i][3]};
#pragma unroll
        for (int i = 0; i < 4; ++i) *(f32x4*)(src + (lane + 64 * i) * 4) = v[i];
    }
}

struct GemmDesc { const bf16_t* A; int lda; const bf16_t* Bt; int K; int Ks; int klen; };
constexpr int LDT = 72;

template <int MI, bool RS, class Epi>
__device__ __forceinline__ void gemm_tile(const GemmDesc& g, int tm, int tn, const Epi& epi, char* smem) {
    constexpr int BM = MI * 64;
    constexpr int NA = MI * 2;
    bf16_t* As = (bf16_t*)smem;
    bf16_t* Bs = As + BM * LDT;
    float* rsc = (float*)(smem + (BM + 128) * LDT * 2);
    const int t = threadIdx.x, lane = t & 63, w = __builtin_amdgcn_readfirstlane(t >> 6), wm = w >> 1, wn = w & 1;
    const int l31 = lane & 31, lh = lane >> 5;
    f32x16 acc[MI][2];
#pragma unroll
    for (int mi = 0; mi < MI; ++mi)
#pragma unroll
        for (int ni = 0; ni < 2; ++ni)
#pragma unroll
            for (int r = 0; r < 16; ++r) acc[mi][ni][r] = 0.f;
    const int lrow = t >> 3, lkc = (t & 7) * 8;
    const bf16_t* Ag = g.A + (size_t)(tm * BM + lrow) * g.lda + lkc;
    const bf16_t* Bg = g.Bt + (size_t)(tn * 128 + lrow) * g.K + lkc;
    u32x4 ra[NA], rb[4];
    float ss[NA];
#pragma unroll
    for (int i = 0; i < NA; ++i) ss[i] = 0.f;
#pragma unroll
    for (int i = 0; i < NA; ++i) ra[i] = *(const u32x4*)(Ag + (size_t)(32 * i) * g.lda);
#pragma unroll
    for (int i = 0; i < 4; ++i) rb[i] = *(const u32x4*)(Bg + (size_t)(32 * i) * g.K);
    const int nk = (g.klen ? g.klen : g.K) / 64;
    for (int kt = 0; kt < nk; ++kt) {
        if (kt) __syncthreads();
#pragma unroll
        for (int i = 0; i < NA; ++i) *(u32x4*)(As + (lrow + 32 * i) * LDT + lkc) = ra[i];
#pragma unroll
        for (int i = 0; i < 4; ++i) *(u32x4*)(Bs + (lrow + 32 * i) * LDT + lkc) = rb[i];
        if (RS) {
            if (kt * 64 < g.Ks) {
#pragma unroll
                for (int i = 0; i < NA; ++i)
#pragma unroll
                    for (int e = 0; e < 4; ++e) { const float a = bf_lo(ra[i][e]), b = bf_hi(ra[i][e]); ss[i] += a * a + b * b; }
            }
            if ((kt + 1) * 64 == g.Ks) {
#pragma unroll
                for (int i = 0; i < NA; ++i) {
                    float s = ss[i];
                    s += __shfl_xor(s, 1); s += __shfl_xor(s, 2); s += __shfl_xor(s, 4);
                    if ((t & 7) == 0) rsc[lrow + 32 * i] = rsqrtf(s / (float)g.Ks + EPS);
                }
            }
        }
        __syncthreads();
        if (kt + 1 < nk) {
            const int k0 = (kt + 1) * 64;
#pragma unroll
            for (int i = 0; i < NA; ++i) ra[i] = *(const u32x4*)(Ag + (size_t)(32 * i) * g.lda + k0);
#pragma unroll
            for (int i = 0; i < 4; ++i) rb[i] = *(const u32x4*)(Bg + (size_t)(32 * i) * g.K + k0);
        }
#pragma unroll
        for (int kk = 0; kk < 4; ++kk) {
            bf16x8 af[MI], bfr[2];
#pragma unroll
            for (int mi = 0; mi < MI; ++mi) af[mi] = *(const bf16x8*)(As + (wm * (MI * 32) + mi * 32 + l31) * LDT + kk * 16 + lh * 8);
#pragma unroll
            for (int ni = 0; ni < 2; ++ni) bfr[ni] = *(const bf16x8*)(Bs + (wn * 64 + ni * 32 + l31) * LDT + kk * 16 + lh * 8);
#pragma unroll
            for (int mi = 0; mi < MI; ++mi)
#pragma unroll
                for (int ni = 0; ni < 2; ++ni) acc[mi][ni] = mfma32(af[mi], bfr[ni], acc[mi][ni]);
        }
        if (RS) {
            if ((kt + 1) * 64 == g.Ks) {
#pragma unroll
                for (int mi = 0; mi < MI; ++mi) {
#pragma unroll
                    for (int g4 = 0; g4 < 4; ++g4) {
                        const f32x4 sv = *(const f32x4*)(rsc + wm * (MI * 32) + mi * 32 + 8 * g4 + 4 * lh);
#pragma unroll
                        for (int e = 0; e < 4; ++e) { acc[mi][0][4 * g4 + e] *= sv[e]; acc[mi][1][4 * g4 + e] *= sv[e]; }
                    }
                    asm volatile("" ::: "memory");
                }
            }
        }
    }
    if (Epi::USES_LDS) __syncthreads();
    epi.template operator()<MI, 0>(acc, tm * BM + wm * (MI * 32), tn * 128 + wn * 64, tn, wn, l31, lh, smem, w);
    if (MI == 4) epi.template operator()<MI, MI - 2>(acc, tm * BM + wm * (MI * 32) + 64, tn * 128 + wn * 64, tn, wn, l31, lh, smem, w);
    __syncthreads();
}


__device__ __forceinline__ u32x4 swap_pair16(u32x2 a  , u32x2 b  ) {
    const auto r0 = __builtin_amdgcn_permlane32_swap(a[0], b[0], false, false);
    const auto r1 = __builtin_amdgcn_permlane32_swap(a[1], b[1], false, false);
    return (u32x4){r0[0], r1[0], r0[1], r1[1]};
}
__device__ __forceinline__ void unswap_pair16(u32x4 wv, u32x2& a, u32x2& b) {
    const auto r0 = __builtin_amdgcn_permlane32_swap(wv[0], wv[2], false, false);
    const auto r1 = __builtin_amdgcn_permlane32_swap(wv[1], wv[3], false, false);
    a = (u32x2){r0[0], r1[0]}; b = (u32x2){r0[1], r1[1]};
}
constexpr int SLD = 68;
__device__ __forceinline__ void stage_store64(float* stg, const f32x16& a0, const f32x16& a1, bf16_t* dst, size_t ld, int l31, int lh) {
#pragma unroll
    for (int r = 0; r < 16; ++r) { stg[crow(r, lh) * SLD + l31] = a0[r]; stg[crow(r, lh) * SLD + 32 + l31] = a1[r]; }
    asm volatile("s_waitcnt lgkmcnt(0)" ::: "memory");
    const int lane = l31 + 32 * lh, rr = lane >> 3, c8 = (lane & 7) * 8;
#pragma unroll
    for (int i = 0; i < 4; ++i) {
        const f32x4 x = *(const f32x4*)(stg + (rr + 8 * i) * SLD + c8), y = *(const f32x4*)(stg + (rr + 8 * i) * SLD + c8 + 4);
        *(u32x4*)(dst + (size_t)(rr + 8 * i) * ld + c8) = (u32x4){pack_bf16(x[0], x[1]), pack_bf16(x[2], x[3]), pack_bf16(y[0], y[1]), pack_bf16(y[2], y[3])};
    }
    asm volatile("s_waitcnt lgkmcnt(0)" ::: "memory");
}
__device__ __forceinline__ void stage_store32(float* stg, const f32x16& a0, bf16_t* dst, size_t ld, int l31, int lh) {
#pragma unroll
    for (int r = 0; r < 16; ++r) stg[crow(r, lh) * SLD + l31] = a0[r];
    asm volatile("s_waitcnt lgkmcnt(0)" ::: "memory");
    const int lane = l31 + 32 * lh, rr = lane >> 2, c8 = (lane & 3) * 8;
#pragma unroll
    for (int i = 0; i < 2; ++i) {
        const f32x4 x = *(const f32x4*)(stg + (rr + 16 * i) * SLD + c8), y = *(const f32x4*)(stg + (rr + 16 * i) * SLD + c8 + 4);
        *(u32x4*)(dst + (size_t)(rr + 16 * i) * ld + c8) = (u32x4){pack_bf16(x[0], x[1]), pack_bf16(x[2], x[3]), pack_bf16(y[0], y[1]), pack_bf16(y[2], y[3])};
    }
    asm volatile("s_waitcnt lgkmcnt(0)" ::: "memory");
}
struct EpiProj0 {
    static constexpr bool USES_LDS = true;
    bf16_t* proj; float* dt_raw; const float* rope;
    template <int MI, int MO> __device__ __forceinline__ void operator()(const f32x16 (&acc)[MI][2], int mbase, int nbase, int tn, int wn, int l31, int lh, char* smem, int w) const {
        float* stg = (float*)smem + w * (32 * SLD);
        if (nbase >= P0W) {
            if (nbase == P0W && l31 < 16) {
#pragma unroll
                for (int mi = 0; mi < 2; ++mi)
#pragma unroll
                    for (int r = 0; r < 16; ++r) dt_raw[(size_t)(mbase + mi * 32 + crow(r, lh)) * 16 + l31] = acc[MO + mi][0][r];
            }
            return;
        }
        if (nbase < 1024) {
            const float sc = nbase >= 512 ? 0.125f : 1.0f;
            const bool lat = mbase >= NCTX;
#pragma unroll
            for (int mi = 0; mi < 2; ++mi) {
                f32x16 y1, y2;
#pragma unroll
                for (int r = 0; r < 16; ++r) {
                    const int row = mbase + mi * 32 + crow(r, lh);
                    float x1 = acc[MO + mi][0][r] * sc, x2 = acc[MO + mi][1][r] * sc;
                    if (lat) {
                        const int pp = (row - NCTX) & (SEQL - 1);
                        const int pos = l31 < 16 ? (pp >> 6) : (pp & 63);
                        const float c = rope[pos * 16 + (l31 & 15)], sn = rope[1024 + pos * 16 + (l31 & 15)];
                        const float t1 = x1 * c - x2 * sn, t2 = x1 * sn + x2 * c; x1 = t1; x2 = t2;
                    }
                    y1[r] = x1; y2[r] = x2;
                }
                stage_store64(stg, y1, y2, proj + (size_t)(mbase + mi * 32) * P0W + nbase, P0W, l31, lh);
            }
            return;
        }
#pragma unroll
        for (int mi = 0; mi < 2; ++mi) stage_store64(stg, acc[MO + mi][0], acc[MO + mi][1], proj + (size_t)(mbase + mi * 32) * P0W + nbase, P0W, l31, lh);
    }
};
struct EpiResid {
    static constexpr bool USES_LDS = true;
    const float* hin_ctx; const float* hin_lat; float* hout_ctx; float* hout_lat; const float* gate_base  ; int row_off;
    template <int MI, int MO> __device__ __forceinline__ void operator()(const f32x16 (&acc)[MI][2], int mbase, int nbase, int tn, int wn, int l31, int lh, char* smem, int w) const {
        const int grow0 = mbase + row_off;
        const float* gp = gate_base + (size_t)cond_of_row(grow0) * 6144;
        const float* hin; float* hout;
        if (grow0 < NCTX) { hin = hin_ctx + (size_t)grow0 * DM; hout = hout_ctx + (size_t)grow0 * DM; }
        else { hin = hin_lat + (size_t)(grow0 - NCTX) * DM; hout = hout_lat + (size_t)(grow0 - NCTX) * DM; }
        float* stg = (float*)smem + w * (32 * SLD);
        const int lane = l31 + 32 * lh;
        const int rr = lane >> 4, c4 = (lane & 15) * 4;
        const f32x4 gt4 = *(const f32x4*)(gp + nbase + c4);
        const int goff = rr * DM + nbase + c4;
#pragma unroll
        for (int mi = 0; mi < 2; ++mi) {
#pragma unroll
            for (int ni = 0; ni < 2; ++ni)
#pragma unroll
                for (int r = 0; r < 16; ++r) stg[crow(r, lh) * SLD + ni * 32 + l31] = acc[MO + mi][ni][r];
            asm volatile("s_waitcnt lgkmcnt(0)" ::: "memory");
#pragma unroll
            for (int i = 0; i < 8; ++i) {
                const f32x4 a = *(const f32x4*)(stg + (rr + 4 * i) * SLD + c4);
                const size_t ro = (size_t)(mi * 32 + 4 * i) * DM;
                const f32x4 hv = *(const f32x4*)(hin + ro + goff);
                *(f32x4*)(hout + ro + goff) = (f32x4){hv[0] + gt4[0] * a[0], hv[1] + gt4[1] * a[1], hv[2] + gt4[2] * a[2], hv[3] + gt4[3] * a[3]};
            }
            asm volatile("s_waitcnt lgkmcnt(0)" ::: "memory");
        }
    }
};
struct EpiResidAtomic {
    static constexpr bool USES_LDS = false;
    float* hout_ctx; const float* gate_base;
    template <int MI, int MO> __device__ __forceinline__ void operator()(const f32x16 (&acc)[MI][2], int mbase, int nbase, int tn, int wn, int l31, int lh, char* smem, int w) const {
        const float* gp = gate_base + (size_t)cond_of_row(mbase) * 6144;
        float* hout = hout_ctx + (size_t)mbase * DM;
        const int loff = 4 * lh * DM + nbase + l31;
#pragma unroll
        for (int ni = 0; ni < 2; ++ni) {
            const float gt = gp[nbase + ni * 32 + l31];
#pragma unroll
            for (int mi = 0; mi < 2; ++mi) {
#pragma unroll
                for (int r = 0; r < 16; ++r) {
                    const size_t ro = (size_t)(mi * 32 + (r & 3) + 8 * (r >> 2)) * DM + ni * 32;
                    unsafeAtomicAdd(hout + ro + loff, gt * acc[MO + mi][ni][r]);
                }
            }
        }
    }
};
struct EpiSwiglu {
    static constexpr bool USES_LDS = true;
    bf16_t* hmid;
    template <int MI, int MO> __device__ __forceinline__ void operator()(const f32x16 (&acc)[MI][2], int mbase, int nbase, int tn, int wn, int l31, int lh, char* smem, int w) const {
        float* stg = (float*)smem + w * (32 * SLD);
#pragma unroll
        for (int mi = 0; mi < 2; ++mi) {
            f32x16 hv;
#pragma unroll
            for (int r = 0; r < 16; ++r) hv[r] = silu_f(acc[MO + mi][0][r]) * acc[MO + mi][1][r];
            stage_store32(stg, hv, hmid + (size_t)(mbase + mi * 32) * DFF + tn * 64 + wn * 32, DFF, l31, lh);
        }
    }
};
struct EpiCqkv {
    static constexpr bool USES_LDS = true;
    bf16_t* cqkv; bf16_t* kpe; const float* rope;
    template <int MI, int MO> __device__ __forceinline__ void operator()(const f32x16 (&acc)[MI][2], int mbase, int nbase, int tn, int wn, int l31, int lh, char* smem, int w) const {
#pragma unroll
        for (int ni = 0; ni < 2; ++ni) {
            const int c0 = nbase + ni * 32;
            if (c0 >= CQW) continue;
            if (c0 == 1024) {
                const bool lat = mbase >= NCTX;
#pragma unroll
                for (int mi = 0; mi < 2; ++mi)
#pragma unroll
                    for (int r = 0; r < 16; ++r) {
                        const int row = mbase + mi * 32 + crow(r, lh);
                        float v = acc[MO + mi][ni][r];
                        if (lat) {
                            const float o = __shfl_xor(v, 16);
                            const int pp = (row - NCTX) & (SEQL - 1);
                            const int i = l31 & 15;
                            const int pos = i < 8 ? (pp >> 6) : (pp & 63);
                            const float c = rope[pos * 8 + (i & 7)], s = rope[512 + pos * 8 + (i & 7)];
                            v = (l31 < 16) ? (v * c - o * s) : (o * s + v * c);
                        }
                        kpe[(size_t)row * 32 + l31] = f2bf(v);
                    }
            } else {
                float* stg = (float*)smem + w * (32 * SLD);
#pragma unroll
                for (int mi = 0; mi < 2; ++mi) stage_store32(stg, acc[MO + mi][ni], cqkv + (size_t)(mbase + mi * 32) * CQW + c0, CQW, l31, lh);
            }
        }
    }
};
struct EpiQ {
    static constexpr bool USES_LDS = true;
    bf16_t* q; const float* rope;
    template <int MI, int MO> __device__ __forceinline__ void operator()(const f32x16 (&acc)[MI][2], int mbase, int nbase, int tn, int wn, int l31, int lh, char* smem, int w) const {
        const float qs = 0.10206207261596575f * 1.4426950408889634f;
        float* stg = (float*)smem + w * (32 * SLD);
#pragma unroll
        for (int ni = 0; ni < 2; ++ni) {
            const int c0 = nbase + ni * 32;
            const bool is_rope = ((c0 >> 5) % 3) == 2;
#pragma unroll
            for (int mi = 0; mi < 2; ++mi) {
                f32x16 y;
#pragma unroll
                for (int r = 0; r < 16; ++r) {
                    const int row = mbase + mi * 32 + crow(r, lh);
                    float v = acc[MO + mi][ni][r] * qs;
                    if (is_rope) {
                        const float o = __shfl_xor(v, 16);
                        const int pp = row & (SEQL - 1);
                        const int i = l31 & 15;
                        const int pos = i < 8 ? (pp >> 6) : (pp & 63);
                        const float c = rope[pos * 8 + (i & 7)], sn = rope[512 + pos * 8 + (i & 7)];
                        v = (l31 < 16) ? (v * c - o * sn) : (o * sn + v * c);
                    }
                    y[r] = v;
                }
                stage_store32(stg, y, q + (size_t)(mbase + mi * 32) * 1536 + c0, 1536, l31, lh);
            }
        }
    }
};
struct EpiKV {
    static constexpr bool USES_LDS = true;
    bf16_t* knope; bf16_t* vt;
    template <int MI, int MO> __device__ __forceinline__ void operator()(const f32x16 (&acc)[MI][2], int mbase, int nbase, int tn, int wn, int l31, int lh, char* smem, int w) const {
        const int head = tn;
        if (wn == 0) {
            float* stg = (float*)smem + w * (32 * SLD);
#pragma unroll
            for (int mi = 0; mi < 2; ++mi) stage_store64(stg, acc[MO + mi][0], acc[MO + mi][1], knope + (size_t)(mbase + mi * 32) * 1024 + head * 64, 1024, l31, lh);
        } else {
            int b, key0;
            if (mbase < NCTX) { b = mbase >> 8; key0 = mbase & 255; } else { b = (mbase - NCTX) >> 12; key0 = CTXL + ((mbase - NCTX) & (SEQL - 1)); }
#pragma unroll
            for (int mi = 0; mi < 2; ++mi)
#pragma unroll
                for (int ni = 0; ni < 2; ++ni) {
                    bf16_t* vp = vt + ((size_t)(b * 16 + head) * 64 + ni * 32 + l31) * NKEY + key0 + mi * 32 + 8 * lh;
#pragma unroll
                    for (int g2 = 0; g2 < 2; ++g2) {
                        const int ga = 2 * g2, gb = 2 * g2 + 1;
                        const u32x2 a = {pack_bf16(acc[MO + mi][ni][4 * ga], acc[MO + mi][ni][4 * ga + 1]), pack_bf16(acc[MO + mi][ni][4 * ga + 2], acc[MO + mi][ni][4 * ga + 3])};
                        const u32x2 bq = {pack_bf16(acc[MO + mi][ni][4 * gb], acc[MO + mi][ni][4 * gb + 1]), pack_bf16(acc[MO + mi][ni][4 * gb + 2], acc[MO + mi][ni][4 * gb + 3])};
                        *(u32x4*)(vp + 16 * g2) = swap_pair16(a, bq);
                    }
                }
        }
    }
};


struct TileOrder {
    int total, per, x, j, nt, mt;
    __device__ __forceinline__ void init(int mt_, int nt_) { mt = mt_; nt = nt_; total = mt_ * nt_; per = (total + 7) >> 3; x = blockIdx.x & 7; j = blockIdx.x >> 3; }
    __device__ __forceinline__ bool get(int k, int& tm, int& tn) const { return at(k * (int)(gridDim.x >> 3) + j, tm, tn); }
    __device__ __forceinline__ bool at(int li, int& tm, int& tn) const {
        if (li >= per) return false;
        const int lin = x * per + li;
        if (lin >= total) return false;
        constexpr int GM = 4;
        const int gsz = GM * nt, gid = lin / gsz, within = lin - gid * gsz;
        const int rem = mt - gid * GM, gm = rem < GM ? rem : GM;
        tm = gid * GM + within % gm; tn = within / gm;
        return true;
    }
};
template <int MI, bool RS, class Epi>
__device__ __forceinline__ void gemm_phase(const GemmDesc& g, int mt, int nt, const Epi& epi, char* smem) {
    TileOrder ord; ord.init(mt, nt);
    int tm, tn;
    for (int k = 0; ord.get(k, tm, tn); ++k) gemm_tile<MI, RS>(g, tm, tn, epi, smem);
}
template <class Epi>
__device__ __forceinline__ void gemm_phase_tail2(const GemmDesc& g, int mt, int nt, const Epi& epi, char* smem) {
    TileOrder ord; ord.init(mt, nt);
    const int slots = gridDim.x >> 3;
    const int R = ord.per / slots, tailn = ord.per - R * slots;
    const bool split = tailn > 0 && 2 * tailn <= slots;
    int tm, tn;
    for (int k = 0; k < (split ? R : R + 1); ++k) { if (ord.get(k, tm, tn)) gemm_tile<4, false>(g, tm, tn, epi, smem); }
    if (split && ord.j < 2 * tailn) {
        const int lin = ord.x * ord.per + R * slots + (ord.j >> 1);
        if (lin < ord.total) {
            constexpr int GM = 4;
            const int gsz = GM * nt, gid = lin / gsz, within = lin - gid * gsz;
            const int rem = mt - gid * GM, gm = rem < GM ? rem : GM;
            tm = gid * GM + within % gm; tn = within / gm;
            gemm_tile<2, false>(g, tm * 2 + (ord.j & 1), tn, epi, smem);
        }
    }
}

__device__ __forceinline__ void conv_phase(const Params& p) {
    const bf16_t* proj = p.big;
    bf16_t* xact = p.abuf;
    const long total = (long)NTOK * 128;
    for (long idx = (long)blockIdx.x * 256 + threadIdx.x; idx < total; idx += (long)gridDim.x * 256) {
        const int row = (int)(idx >> 7), c8 = ((int)idx & 127) * 8;
        int tpos, len;
        if (row < NCTX) { tpos = row & (CTXL - 1); len = CTXL; } else { tpos = (row - NCTX) & (SEQL - 1); len = SEQL; }
        float a[8];
        { const f32x4 b0 = *(const f32x4*)(p.conv_b + c8), b1 = *(const f32x4*)(p.conv_b + c8 + 4);
          a[0] = b0[0]; a[1] = b0[1]; a[2] = b0[2]; a[3] = b0[3]; a[4] = b1[0]; a[5] = b1[1]; a[6] = b1[2]; a[7] = b1[3]; }
#pragma unroll
        for (int j = 0; j < 5; ++j) {
            const int tt = tpos + j - 2;
            if (tt < 0 || tt >= len) continue;
            const u32x4 xv = *(const u32x4*)(proj + (size_t)(row + j - 2) * P0W + 2560 + c8);
            const f32x4 w0 = *(const f32x4*)(p.conv_w + j * 1024 + c8), w1 = *(const f32x4*)(p.conv_w + j * 1024 + c8 + 4);
            a[0] += w0[0] * bf_lo(xv[0]); a[1] += w0[1] * bf_hi(xv[0]); a[2] += w0[2] * bf_lo(xv[1]); a[3] += w0[3] * bf_hi(xv[1]);
            a[4] += w1[0] * bf_lo(xv[2]); a[5] += w1[1] * bf_hi(xv[2]); a[6] += w1[2] * bf_lo(xv[3]); a[7] += w1[3] * bf_hi(xv[3]);
        }
#pragma unroll
        for (int e = 0; e < 8; ++e) a[e] = silu_f(a[e]);
        *(u32x4*)(xact + (size_t)row * 1024 + c8) = (u32x4){pack_bf16(a[0], a[1]), pack_bf16(a[2], a[3]), pack_bf16(a[4], a[5]), pack_bf16(a[6], a[7])};
    }
    const int total2 = NTOK * 16;
    for (int idx = blockIdx.x * 256 + threadIdx.x; idx < total2; idx += gridDim.x * 256) {
        const int dh = idx & 15;
        const float xr = p.dt_raw[idx] + p.dt_bias[dh];
        const float dt = xr > 20.f ? xr : log1pf(__expf(xr));
        p.dtv[idx] = dt;
        p.la[idx] = -dt * __expf(p.a_log[dh]);
    }
}

constexpr int LDV = 136;
struct ScanItem { int b, n, hh, h, rowb; bool isret; };
__device__ __forceinline__ ScanItem scan_item(int item) {
    ScanItem s; s.hh = item / (NBATCH * NCHUNK); const int bn = item % (NBATCH * NCHUNK); s.n = bn % NCHUNK; s.b = bn / NCHUNK;
    s.isret = s.hh < 8; s.h = s.hh & 7;
    s.rowb = s.n < 2 ? s.b * CTXL + s.n * 128 : NCTX + s.b * SEQL + (s.n - 2) * 128;
    return s;
}
__device__ __forceinline__ float log_sigmoid_f(float x) { return fminf(x, 0.f) - log1pf(__expf(-fabsf(x))); }
__device__ __forceinline__ void scan_cums(const Params& p, const ScanItem& s, float* cumf, float* cumb, float* vsf, float* vsb, float* xch) {
    const int t = threadIdx.x, lane = t & 63, w = t >> 6;
    const int dir = t >> 7, tt = t & 127;
    const int j = dir == 0 ? tt : 127 - tt;
    float la, vs;
    if (s.isret) { la = log_sigmoid_f(p.decay_logit[dir * 8 + s.h]); vs = 1.0f; }
    else { la = p.la[(size_t)(s.rowb + j) * 16 + dir * 8 + s.h]; vs = p.dtv[(size_t)(s.rowb + j) * 16 + dir * 8 + s.h]; }
    float v = la;
#pragma unroll
    for (int o = 1; o < 64; o <<= 1) { const float u = __shfl_up(v, o); if (lane >= o) v += u; }
    if (lane == 63) xch[w] = v;
    __syncthreads();
    if (w & 1) v += xch[w - 1];
    if (dir == 0) { cumf[j] = v; vsf[j] = vs; } else { cumb[j] = v; vsb[j] = vs; }
    __syncthreads();
}

__device__ __forceinline__ void scan_state_phase(const Params& p, char* smem) {
    bf16_t* Vtf = (bf16_t*)smem;
    bf16_t* Vtb = Vtf + 64 * LDV;
    bf16_t* Kt = Vtb + 64 * LDV;
    float* cumf = (float*)(Kt + 64 * LDV);
    float* cumb = cumf + 128; float* vsf = cumb + 128; float* vsb = vsf + 128; float* wf = vsb + 128; float* wb = wf + 128; float* xch = wb + 128;
    const int t = threadIdx.x, lane = t & 63, w = t >> 6, l31 = lane & 31, lh = lane >> 5;
    for (int item = blockIdx.x; item < NITEM; item += gridDim.x) {
        const ScanItem s = scan_item(item);
        scan_cums(p, s, cumf, cumb, vsf, vsb, xch);
        if (t < 128) wf[t] = __expf(cumf[127] - cumf[t]) * vsf[t]; else wb[t - 128] = __expf(cumb[0] - cumb[t - 128]) * vsb[t - 128];
        if (t == 0) { p.tot[item * 2 + 0] = __expf(cumf[127]); p.tot[item * 2 + 1] = __expf(cumb[0]); }
        __syncthreads();
        const bf16_t* vsrc; int ldv_; const bf16_t* ksrc; int ldk_; int dk;
        if (s.isret) { vsrc = p.big + (size_t)s.rowb * P0W + 1024 + s.h * 64; ldv_ = P0W; ksrc = p.big + (size_t)s.rowb * P0W + 512 + s.h * 64; ldk_ = P0W; dk = 64; }
        else { vsrc = p.abuf + (size_t)s.rowb * 1024 + s.h * 64; ldv_ = 1024; ksrc = p.abuf + (size_t)s.rowb * 1024 + 512 + (s.h >> 2) * 128; ldk_ = 1024; dk = 128; }
#pragma unroll
        for (int i = 0; i < 2; ++i) {
            const int u = t + 256 * i, jp = u >> 3, vc = (u & 7) * 8;
            const u32x4 xa = *(const u32x4*)(vsrc + (size_t)(2 * jp) * ldv_ + vc), xb = *(const u32x4*)(vsrc + (size_t)(2 * jp + 1) * ldv_ + vc);
            const float fa = wf[2 * jp], fb = wf[2 * jp + 1], ba = wb[2 * jp], bbv = wb[2 * jp + 1];
#pragma unroll
            for (int e = 0; e < 4; ++e) {
                const float loa = bf_lo(xa[e]), hia = bf_hi(xa[e]), lob = bf_lo(xb[e]), hib = bf_hi(xb[e]);
                *(unsigned*)(Vtf + (vc + 2 * e) * LDV + 2 * jp) = pack_bf16(loa * fa, lob * fb);
                *(unsigned*)(Vtf + (vc + 2 * e + 1) * LDV + 2 * jp) = pack_bf16(hia * fa, hib * fb);
                *(unsigned*)(Vtb + (vc + 2 * e) * LDV + 2 * jp) = pack_bf16(loa * ba, lob * bbv);
                *(unsigned*)(Vtb + (vc + 2 * e + 1) * LDV + 2 * jp) = pack_bf16(hia * ba, hib * bbv);
            }
        }
        bf16_t* stbase = s.isret ? p.st_ret + ((size_t)((s.b * NCHUNK + s.n) * 8 + s.h) * 2) * 4096
                                 : p.st_ssd + ((size_t)((s.b * NCHUNK + s.n) * 8 + s.h) * 2) * 8192;
        for (int dh = 0; dh < dk / 64; ++dh) {
#pragma unroll
            for (int i = 0; i < 2; ++i) {
                const int u = t + 256 * i, jp = u >> 3, dc = (u & 7) * 8;
                const u32x4 xa = *(const u32x4*)(ksrc + (size_t)(2 * jp) * ldk_ + dh * 64 + dc), xb = *(const u32x4*)(ksrc + (size_t)(2 * jp + 1) * ldk_ + dh * 64 + dc);
#pragma unroll
                for (int e = 0; e < 4; ++e) {
                    *(unsigned*)(Kt + (dc + 2 * e) * LDV + 2 * jp) = (xa[e] & 0xffffu) | (xb[e] << 16);
                    *(unsigned*)(Kt + (dc + 2 * e + 1) * LDV + 2 * jp) = (xa[e] >> 16) | (xb[e] & 0xffff0000u);
                }
            }
            __syncthreads();
            const int dir = w >> 1, vt = w & 1;
            const bf16_t* Vw = dir ? Vtb : Vtf;
            bf16_t* st = stbase + (size_t)dir * 64 * dk;
#pragma unroll
            for (int dt = 0; dt < 2; ++dt) {
                f32x16 acc;
#pragma unroll
                for (int r = 0; r < 16; ++r) acc[r] = 0.f;
#pragma unroll
                for (int st8 = 0; st8 < 8; ++st8) {
                    const bf16x8 a = *(const bf16x8*)(Kt + (dt * 32 + l31) * LDV + st8 * 16 + lh * 8);
                    const bf16x8 bq = *(const bf16x8*)(Vw + (vt * 32 + l31) * LDV + st8 * 16 + lh * 8);
                    acc = mfma32(a, bq, acc);
                }
#pragma unroll
                for (int g2 = 0; g2 < 2; ++g2) {
                    const int ga = 2 * g2, gb = 2 * g2 + 1;
                    const u32x2 a = {pack_bf16(acc[4 * ga], acc[4 * ga + 1]), pack_bf16(acc[4 * ga + 2], acc[4 * ga + 3])};
                    const u32x2 bq = {pack_bf16(acc[4 * gb], acc[4 * gb + 1]), pack_bf16(acc[4 * gb + 2], acc[4 * gb + 3])};
                    *(u32x4*)(st + (size_t)(vt * 32 + l31) * dk + dh * 64 + dt * 32 + 16 * g2 + 8 * lh) = swap_pair16(a, bq);
                }
            }
            __syncthreads();
        }
    }
}

__device__ __forceinline__ void scan_pass_phase(const Params& p) {
    const int total = NBATCH * 2 * 12288;
    for (int gid = blockIdx.x * 256 + threadIdx.x; gid < total; gid += gridDim.x * 256) {
        const int bd = gid / 12288, e = gid % 12288;
        const int b = bd >> 1, dir = bd & 1;
        bf16_t* base; int E, h, e8, hh;
        if (e < 4096) { h = e >> 9; e8 = (e & 511) * 8; E = 4096; base = p.st_ret; hh = h; }
        else { const int e2 = e - 4096; h = e2 >> 10; e8 = (e2 & 1023) * 8; E = 8192; base = p.st_ssd; hh = 8 + h; }
        float S[8];
#pragma unroll
        for (int i = 0; i < 8; ++i) S[i] = 0.f;
        for (int step = 0; step < NCHUNK; ++step) {
            const int n = dir == 0 ? step : (step == 0 ? 1 : (step == 1 ? 0 : 35 - step));
            bf16_t* ptr = base + ((size_t)((b * NCHUNK + n) * 8 + h) * 2 + dir) * E + e8;
            const u32x4 kv = *(const u32x4*)ptr;
            const float tt = p.tot[(hh * (NBATCH * NCHUNK) + b * NCHUNK + n) * 2 + dir];
            *(u32x4*)ptr = (u32x4){pack_bf16(S[0], S[1]), pack_bf16(S[2], S[3]), pack_bf16(S[4], S[5]), pack_bf16(S[6], S[7])};
#pragma unroll
            for (int i = 0; i < 4; ++i) { S[2 * i] = tt * S[2 * i] + bf_lo(kv[i]); S[2 * i + 1] = tt * S[2 * i + 1] + bf_hi(kv[i]); }
        }
    }
}

template <int DK>
__device__ __forceinline__ void scan_out_item(const Params& p, const ScanItem& s, bf16_t* Vt, const float* cumf, const float* cumb, const float* vsf, const float* vsb) {
    const int t = threadIdx.x, lane = t & 63, w = t >> 6, l31 = lane & 31, lh = lane >> 5;
    constexpr int NS = DK / 16;
    const bf16_t* qsrc; const bf16_t* ksrc; int ld;
    if (DK == 64) { qsrc = p.big + (size_t)s.rowb * P0W + s.h * 64; ksrc = qsrc + 512; ld = P0W; }
    else { ksrc = p.abuf + (size_t)s.rowb * 1024 + 512 + (s.h >> 2) * 128; qsrc = ksrc + 256; ld = 1024; }
    const int iq = w * 32 + l31;
    bf16x8 qf[NS];
#pragma unroll
    for (int st = 0; st < NS; ++st) qf[st] = *(const bf16x8*)(qsrc + (size_t)iq * ld + st * 16 + lh * 8);
    f32x16 O[2];
#pragma unroll
    for (int r = 0; r < 16; ++r) { O[0][r] = 0.f; O[1][r] = 0.f; }
    const float cif = cumf[iq], cib = cumb[iq];
#pragma unroll 1
    for (int kt = 0; kt < 4; ++kt) {
        f32x16 sT;
#pragma unroll
        for (int r = 0; r < 16; ++r) sT[r] = 0.f;
#pragma unroll
        for (int st = 0; st < NS; ++st) {
            const bf16x8 kf = *(const bf16x8*)(ksrc + (size_t)(kt * 32 + l31) * ld + st * 16 + lh * 8);
            sT = mfma32(kf, qf[st], sT);
        }
        const int wu = __builtin_amdgcn_readfirstlane(w);
        if (kt < wu) {
#pragma unroll
            for (int r = 0; r < 16; ++r) { const int j = kt * 32 + crow(r, lh); sT[r] *= __expf(cif - cumf[j]) * vsf[j]; }
        } else if (kt > wu) {
#pragma unroll
            for (int r = 0; r < 16; ++r) { const int j = kt * 32 + crow(r, lh); sT[r] *= __expf(cib - cumb[j]) * vsb[j]; }
        } else {
#pragma unroll
            for (int r = 0; r < 16; ++r) {
                const int j = kt * 32 + crow(r, lh);
                const float dec = (j <= iq) ? __expf(cif - cumf[j]) * vsf[j] : __expf(cib - cumb[j]) * vsb[j];
                sT[r] *= dec;
            }
        }
#pragma unroll
        for (int ts = 0; ts < 2; ++ts) {
            const u32x4 pk = {pack_bf16(sT[8 * ts + 0], sT[8 * ts + 1]), pack_bf16(sT[8 * ts + 2], sT[8 * ts + 3]), pack_bf16(sT[8 * ts + 4], sT[8 * ts + 5]), pack_bf16(sT[8 * ts + 6], sT[8 * ts + 7])};
            const bf16x8 pb = as_bf16x8(pk);
#pragma unroll
            for (int vt = 0; vt < 2; ++vt) {
                const bf16_t* vp = Vt + (vt * 32 + l31) * LDV + kt * 32 + 16 * ts + 4 * lh;
                const u32x2 v0 = *(const u32x2*)vp, v1 = *(const u32x2*)(vp + 8);
                O[vt] = mfma32(as_bf16x8((u32x4){v0[0], v0[1], v1[0], v1[1]}), pb, O[vt]);
            }
        }
    }
    const bf16_t* stb = (DK == 64) ? p.st_ret + ((size_t)((s.b * NCHUNK + s.n) * 8 + s.h) * 2) * 4096
                                   : p.st_ssd + ((size_t)((s.b * NCHUNK + s.n) * 8 + s.h) * 2) * 8192;
#pragma unroll
    for (int dir = 0; dir < 2; ++dir) {
        const float ee = __expf(dir == 0 ? cif : cib);
#pragma unroll
        for (int vt = 0; vt < 2; ++vt) {
            f32x16 T;
#pragma unroll
            for (int r = 0; r < 16; ++r) T[r] = 0.f;
#pragma unroll
            for (int st = 0; st < NS; ++st) {
                const bf16x8 sa = *(const bf16x8*)(stb + (size_t)dir * 64 * DK + (size_t)(vt * 32 + l31) * DK + st * 16 + lh * 8);
                T = mfma32(sa, qf[st], T);
            }
#pragma unroll
            for (int r = 0; r < 16; ++r) O[vt][r] += ee * T[r];
        }
    }
    const int row = s.rowb + iq;
    if (DK == 64) {
        float sm = 0.f;
#pragma unroll
        for (int r = 0; r < 16; ++r) sm += O[0][r] + O[1][r];
        sm += __shfl_xor(sm, 32);
        const float mu = sm * (1.0f / 64.0f);
        float vr = 0.f;
#pragma unroll
        for (int r = 0; r < 16; ++r) { const float d0 = O[0][r] - mu, d1 = O[1][r] - mu; vr += d0 * d0 + d1 * d1; }
        vr += __shfl_xor(vr, 32);
        const float rstd = rsqrtf(vr * (1.0f / 64.0f) + EPS);
        bf16_t* gp = p.big + (size_t)row * P0W + 2048 + s.h * 64;
#pragma unroll
        for (int vt = 0; vt < 2; ++vt) {
            u32x2 gv[4]; f32x4 gw[4];
#pragma unroll
            for (int g2 = 0; g2 < 2; ++g2) unswap_pair16(*(const u32x4*)(gp + vt * 32 + 16 * g2 + 8 * lh), gv[2 * g2], gv[2 * g2 + 1]);
#pragma unroll
            for (int g4 = 0; g4 < 4; ++g4) gw[g4] = *(const f32x4*)(p.gn_w + s.h * 64 + vt * 32 + 8 * g4 + 4 * lh);
            u32x2 ov[4];
#pragma unroll
            for (int g4 = 0; g4 < 4; ++g4) {
                const float y0 = (O[vt][4 * g4 + 0] - mu) * rstd * gw[g4][0] * silu_f(bf_lo(gv[g4][0]));
                const float y1 = (O[vt][4 * g4 + 1] - mu) * rstd * gw[g4][1] * silu_f(bf_hi(gv[g4][0]));
                const float y2 = (O[vt][4 * g4 + 2] - mu) * rstd * gw[g4][2] * silu_f(bf_lo(gv[g4][1]));
                const float y3 = (O[vt][4 * g4 + 3] - mu) * rstd * gw[g4][3] * silu_f(bf_hi(gv[g4][1]));
                ov[g4] = (u32x2){pack_bf16(y0, y1), pack_bf16(y2, y3)};
            }
#pragma unroll
            for (int g2 = 0; g2 < 2; ++g2) *(u32x4*)(gp + vt * 32 + 16 * g2 + 8 * lh) = swap_pair16(ov[2 * g2], ov[2 * g2 + 1]);
        }
    } else {
        const float dsk = p.ssd_d[s.h];
        bf16_t* zp = p.big + (size_t)row * P0W + 1536 + s.h * 64;
        const bf16_t* xp = p.abuf + (size_t)row * 1024 + s.h * 64;
        u32x2 zv[2][4], xv[2][4];
#pragma unroll
        for (int vt = 0; vt < 2; ++vt)
#pragma unroll
            for (int g2 = 0; g2 < 2; ++g2) {
                unswap_pair16(*(const u32x4*)(zp + vt * 32 + 16 * g2 + 8 * lh), zv[vt][2 * g2], zv[vt][2 * g2 + 1]);
                unswap_pair16(*(const u32x4*)(xp + vt * 32 + 16 * g2 + 8 * lh), xv[vt][2 * g2], xv[vt][2 * g2 + 1]);
            }
        u32x2 ov[2][4];
#pragma unroll
        for (int vt = 0; vt < 2; ++vt)
#pragma unroll
            for (int g4 = 0; g4 < 4; ++g4) {
                const float y0 = (O[vt][4 * g4 + 0] + dsk * bf_lo(xv[vt][g4][0])) * silu_f(bf_lo(zv[vt][g4][0]));
                const float y1 = (O[vt][4 * g4 + 1] + dsk * bf_hi(xv[vt][g4][0])) * silu_f(bf_hi(zv[vt][g4][0]));
                const float y2 = (O[vt][4 * g4 + 2] + dsk * bf_lo(xv[vt][g4][1])) * silu_f(bf_lo(zv[vt][g4][1]));
                const float y3 = (O[vt][4 * g4 + 3] + dsk * bf_hi(xv[vt][g4][1])) * silu_f(bf_hi(zv[vt][g4][1]));
                ov[vt][g4] = (u32x2){pack_bf16(y0, y1), pack_bf16(y2, y3)};
            }
#pragma unroll
        for (int vt = 0; vt < 2; ++vt)
#pragma unroll
            for (int g2 = 0; g2 < 2; ++g2) *(u32x4*)(zp + vt * 32 + 16 * g2 + 8 * lh) = swap_pair16(ov[vt][2 * g2], ov[vt][2 * g2 + 1]);
    }
}

__device__ __forceinline__ void scan_out_phase(const Params& p, char* smem) {
    bf16_t* Vt = (bf16_t*)smem;
    float* cumf = (float*)(Vt + 64 * LDV);
    float* cumb = cumf + 128; float* vsf = cumb + 128; float* vsb = vsf + 128; float* xch = vsb + 128;
    const int t = threadIdx.x;
    for (int item = blockIdx.x; item < NITEM; item += gridDim.x) {
        const ScanItem s = scan_item(item);
        scan_cums(p, s, cumf, cumb, vsf, vsb, xch);
        const bf16_t* vsrc; int ldv_;
        if (s.isret) { vsrc = p.big + (size_t)s.rowb * P0W + 1024 + s.h * 64; ldv_ = P0W; }
        else { vsrc = p.abuf + (size_t)s.rowb * 1024 + s.h * 64; ldv_ = 1024; }
#pragma unroll
        for (int i = 0; i < 2; ++i) {
            const int u = t + 256 * i, jp = u >> 3, vc = (u & 7) * 8;
            const u32x4 xa = *(const u32x4*)(vsrc + (size_t)(2 * jp) * ldv_ + vc), xb = *(const u32x4*)(vsrc + (size_t)(2 * jp + 1) * ldv_ + vc);
#pragma unroll
            for (int e = 0; e < 4; ++e) {
                *(unsigned*)(Vt + (vc + 2 * e) * LDV + 2 * jp) = (xa[e] & 0xffffu) | (xb[e] << 16);
                *(unsigned*)(Vt + (vc + 2 * e + 1) * LDV + 2 * jp) = (xa[e] >> 16) | (xb[e] & 0xffff0000u);
            }
        }
        __syncthreads();
        if (s.isret) scan_out_item<64>(p, s, Vt, cumf, cumb, vsf, vsb);
        else scan_out_item<128>(p, s, Vt, cumf, cumb, vsf, vsb);
        __syncthreads();
    }
}

constexpr int LDK = 104, LDVT = 72, KT = 64;
__device__ __forceinline__ void attn_phase(const Params& p, const bf16_t* qbuf, const bf16_t* knope, const bf16_t* vtg, bf16_t* obuf, char* smem) {
    bf16_t* Lb = (bf16_t*)smem;
    constexpr int KVB = KT * LDK + 64 * LDVT;
    const int t = threadIdx.x, lane = t & 63, w = __builtin_amdgcn_readfirstlane(t >> 6), l31 = lane & 31, lh = lane >> 5;
    const int xj = blockIdx.x >> 3, ppr = (gridDim.x >> 3) >> 4;
    for (int k = 0; ppr > 0; ++k) {
        const int pi = (blockIdx.x & 7) + 8 * (k * ppr + (xj >> 4));
        if (pi >= NBATCH * 16 || (xj >> 4) >= ppr) break;
        const int qb = xj & 15, hd = pi & 15, b = pi >> 4;
        const int m0 = b * SEQL + qb * 256 + w * 64 + l31;
        bf16x8 qf[2][6];
#pragma unroll
        for (int qt = 0; qt < 2; ++qt)
#pragma unroll
            for (int st = 0; st < 6; ++st) qf[qt][st] = *(const bf16x8*)(qbuf + (size_t)(m0 + 32 * qt) * 1536 + hd * 96 + st * 16 + lh * 8);
        f32x16 O[2][2];
#pragma unroll
        for (int r = 0; r < 16; ++r) { O[0][0][r] = 0.f; O[0][1][r] = 0.f; O[1][0][r] = 0.f; O[1][1][r] = 0.f; }
        float mrun[2] = {-1e30f, -1e30f}, lsum[2] = {0.f, 0.f};
        u32x4 rk[3], rv[2];
        const bf16_t* vbase = vtg + (size_t)(b * 16 + hd) * 64 * NKEY;
        const int kn_off0 = (t >> 3) * 1024 + (t & 7) * 8, kn_off1 = kn_off0 + 32 * 1024;
        const int kp_off = (t >> 2) * 32 + (t & 3) * 8;
        const int v_off0 = (t >> 3) * NKEY + (t & 7) * 8, v_off1 = v_off0 + 32 * NKEY;
        const int kn_lds0 = (t >> 3) * LDK + (t & 7) * 8, kn_lds1 = kn_lds0 + 32 * LDK, kp_lds = (t >> 2) * LDK + 64 + (t & 3) * 8;
        const int v_lds0 = (t >> 3) * LDVT + (t & 7) * 8, v_lds1 = v_lds0 + 32 * LDVT;
        auto gload = [&](int tile) {
            const int k0 = tile * KT;
            const int rowk0 = k0 < CTXL ? b * CTXL + k0 : NCTX + b * SEQL + (k0 - CTXL);
            const bf16_t* knb = knope + (size_t)rowk0 * 1024 + hd * 64;
            const bf16_t* kpb = p.kpe + (size_t)rowk0 * 32;
            const bf16_t* vb = vbase + k0;
            rk[0] = *(const u32x4*)(knb + kn_off0); rk[1] = *(const u32x4*)(knb + kn_off1); rk[2] = *(const u32x4*)(kpb + kp_off);
            rv[0] = *(const u32x4*)(vb + v_off0); rv[1] = *(const u32x4*)(vb + v_off1);
        };
        auto lwrite = [&](int buf) {
            bf16_t* Kb = Lb + buf * KVB; bf16_t* Vb = Kb + KT * LDK;
            *(u32x4*)(Kb + kn_lds0) = rk[0]; *(u32x4*)(Kb + kn_lds1) = rk[1]; *(u32x4*)(Kb + kp_lds) = rk[2];
            *(u32x4*)(Vb + v_lds0) = rv[0]; *(u32x4*)(Vb + v_lds1) = rv[1];
        };
        gload(0); lwrite(0); gload(1);
        constexpr int NT = NKEY / KT;
        for (int tile = 0; tile < NT; ++tile) {
            __syncthreads();
            if (tile + 1 < NT) { lwrite((tile + 1) & 1); if (tile + 2 < NT) gload(tile + 2); }
            const bf16_t* Ksm = Lb + (tile & 1) * KVB;
            const bf16_t* Vsm = Ksm + KT * LDK;
#pragma unroll
            for (int ks = 0; ks < 2; ++ks) {
                f32x16 sT[2];
#pragma unroll
                for (int r = 0; r < 16; ++r) { sT[0][r] = 0.f; sT[1][r] = 0.f; }
#pragma unroll
                for (int st = 0; st < 6; ++st) {
                    const bf16x8 kf = *(const bf16x8*)(Ksm + (ks * 32 + l31) * LDK + st * 16 + lh * 8);
                    sT[0] = mfma32(kf, qf[0][st], sT[0]);
                    sT[1] = mfma32(kf, qf[1][st], sT[1]);
                }
                u32x4 pbq[2][2];
#pragma unroll
                for (int qt = 0; qt < 2; ++qt) {
                    float mx = sT[qt][0];
#pragma unroll
                    for (int r = 1; r < 16; ++r) mx = fmaxf(mx, sT[qt][r]);
                    if (__builtin_amdgcn_ballot_w64(mx > mrun[qt] + 8.0f) != 0ull) {
                        mx = fmaxf(mx, __shfl_xor(mx, 32));
                        const float mnew = fmaxf(mrun[qt], mx);
                        const float alpha = __builtin_amdgcn_exp2f(mrun[qt] - mnew);
                        mrun[qt] = mnew;
                        lsum[qt] *= alpha;
#pragma unroll
                        for (int r = 0; r < 16; ++r) { O[qt][0][r] *= alpha; O[qt][1][r] *= alpha; }
                    }
                    float ls4[4] = {0.f, 0.f, 0.f, 0.f};
#pragma unroll
                    for (int r = 0; r < 16; ++r) {
                        const float pe = __builtin_amdgcn_exp2f(sT[qt][r] - mrun[qt]);
                        sT[qt][r] = pe;
                        ls4[r & 3] += pe;
                    }
                    lsum[qt] += (ls4[0] + ls4[1]) + (ls4[2] + ls4[3]);
#pragma unroll
                    for (int ts = 0; ts < 2; ++ts)
                        pbq[qt][ts] = (u32x4){pack_bf16(sT[qt][8 * ts + 0], sT[qt][8 * ts + 1]), pack_bf16(sT[qt][8 * ts + 2], sT[qt][8 * ts + 3]),
                                              pack_bf16(sT[qt][8 * ts + 4], sT[qt][8 * ts + 5]), pack_bf16(sT[qt][8 * ts + 6], sT[qt][8 * ts + 7])};
                }
#pragma unroll
                for (int ts = 0; ts < 2; ++ts)
#pragma unroll
                    for (int vt = 0; vt < 2; ++vt) {
                        const bf16_t* vp = Vsm + (vt * 32 + l31) * LDVT + ks * 32 + 16 * ts + 4 * lh;
                        const u32x2 v0 = *(const u32x2*)vp, v1 = *(const u32x2*)(vp + 8);
                        const bf16x8 va = as_bf16x8((u32x4){v0[0], v0[1], v1[0], v1[1]});
                        O[0][vt] = mfma32(va, as_bf16x8(pbq[0][ts]), O[0][vt]);
                        O[1][vt] = mfma32(va, as_bf16x8(pbq[1][ts]), O[1][vt]);
                    }
            }
        }
#pragma unroll
        for (int qt = 0; qt < 2; ++qt) {
            const float lt = lsum[qt] + __shfl_xor(lsum[qt], 32);
            const float inv = 1.0f / lt;
            bf16_t* op = obuf + (size_t)(m0 + 32 * qt) * 1024 + hd * 64;
#pragma unroll
            for (int vt = 0; vt < 2; ++vt)
#pragma unroll
                for (int g2 = 0; g2 < 2; ++g2) {
                    const int ga = 2 * g2, gb = 2 * g2 + 1;
                    const u32x2 a = {pack_bf16(O[qt][vt][4 * ga] * inv, O[qt][vt][4 * ga + 1] * inv), pack_bf16(O[qt][vt][4 * ga + 2] * inv, O[qt][vt][4 * ga + 3] * inv)};
                    const u32x2 b = {pack_bf16(O[qt][vt][4 * gb] * inv, O[qt][vt][4 * gb + 1] * inv), pack_bf16(O[qt][vt][4 * gb + 2] * inv, O[qt][vt][4 * gb + 3] * inv)};
                    *(u32x4*)(op + vt * 32 + 16 * g2 + 8 * lh) = swap_pair16(a, b);
                }
        }
        __syncthreads();
    }
}

__device__ __forceinline__ void run_phase(const Params& p, int ph, char* smem) {
    bf16_t* cqkv = p.big;
    bf16_t* qbuf = p.big + (size_t)NTOK * CQW;
    bf16_t* knope = qbuf + (size_t)NLAT * 1536;
    bf16_t* obuf = p.big;
    bf16_t* hmid = p.big;
    switch (ph) {
    case 0: if ((PHASE_MASK >> 0) & 1) {
        const int total = 384 + WC0_TILES + 1;
        for (int it = blockIdx.x; it < total; it += gridDim.x) {
            if (it < 384) adaln_item(p, it, smem);
            else if (it < 384 + WC0_TILES) wconv_item(p, 0, it - 384, smem);
            else rope_item(p);
        }
    } break;
    case 1: if ((PHASE_MASK >> 1) & 1) norm_mod_phase(p, 0, 0, 0, 0, NTOK); break;
    case 2: if ((PHASE_MASK >> 2) & 1) { GemmDesc g{p.abuf, DM, p.wt_in0, 1024, 0}; EpiProj0 e{p.big, p.dt_raw, p.rope_ret}; gemm_phase<4, false>(g, NTOK / 256, 29, e, smem); } break;
    case 3: if ((PHASE_MASK >> 3) & 1) conv_phase(p); break;
    case 4: if ((PHASE_MASK >> 4) & 1) scan_state_phase(p, smem); break;
    case 5: if ((PHASE_MASK >> 5) & 1) scan_pass_phase(p); break;
    case 6: if ((PHASE_MASK >> 6) & 1) scan_out_phase(p, smem); break;
    case 7: if ((PHASE_MASK >> 7) & 1) { GemmDesc g{p.big + 1536, P0W, p.wt_out0, 1024, 512}; EpiResid e{p.ctx, p.x, p.hctx, p.out, p.ada + 2 * 1024, 0}; GemmDesc gl = g; gl.A = g.A + (size_t)NCTX * P0W; EpiResid el = e; el.row_off = NCTX;
        TileOrder ord; ord.init(NLAT / 256, 8);
        int tm, tn;
        for (int k = 0; ord.get(k, tm, tn); ++k) gemm_tile<4, true>(gl, tm, tn, el, smem);
        for (int it = blockIdx.x; it < (NCTX / 128) * 8; it += gridDim.x) gemm_tile<2, true>(g, it / 8, it % 8, e, smem);
        } break;
    case 8: if ((PHASE_MASK >> 8) & 1) {
        norm_mod_phase(p, 1, 0, 3, 0, NTOK);
        for (int it = blockIdx.x; it < WC1_TILES; it += gridDim.x) wconv_item(p, 1, it, smem);
    } break;
    case 9: if ((PHASE_MASK >> 9) & 1) { GemmDesc g{p.abuf, DM, p.wt_f1_0, 1024, 0}; EpiSwiglu e{hmid}; gemm_phase<4, false>(g, NTOK / 256, 44, e, smem); } break;
    case 10: if ((PHASE_MASK >> 10) & 1) { GemmDesc g{hmid, DFF, p.wt_f2_0, DFF, 0}; EpiResid e{p.hctx, p.out, p.hctx, p.out, p.ada + 5 * 1024, 0};
        const int tc = (NCTX / 128) * 8 * 4;
        GemmDesc gl = g; gl.A = g.A + (size_t)NCTX * DFF; EpiResid el = e; el.row_off = NCTX;
        EpiResidAtomic ea{p.hctx, p.ada + 5 * 1024};
        {
            TileOrder ord; ord.init(NLAT / 256, 8);
            int tm, tn;
            for (int k = 0; ord.get(k, tm, tn); ++k) gemm_tile<4, false>(gl, tm, tn, el, smem);
        }
        for (int c = blockIdx.x; c < tc; c += gridDim.x) {
            const int tile = c >> 2, ks = c & 3;
            GemmDesc gc = g; gc.A = g.A + ks * (DFF / 4); gc.Bt = g.Bt + ks * (DFF / 4); gc.klen = DFF / 4;
            gemm_tile<2, false>(gc, tile / 8, tile % 8, ea, smem);
        } } break;
    case 11: if ((PHASE_MASK >> 11) & 1) norm_mod_phase(p, 1, 1, 0, 0, NTOK); break;
    case 12: if ((PHASE_MASK >> 12) & 1) { GemmDesc g{p.abuf, DM, p.wt_mla_in, 1024, 0}; EpiCqkv e{cqkv, p.kpe, p.rope_mla}; gemm_phase_tail2(g, NTOK / 256, 9, e, smem); } break;
    case 13: if ((PHASE_MASK >> 13) & 1) {
        GemmDesc gq{cqkv + (size_t)NCTX * CQW, CQW, p.wt_uq, 768, 768}; EpiQ eq{qbuf, p.rope_mla};
        GemmDesc gk{cqkv + 768, CQW, p.wt_ukv, 256, 256}; EpiKV ek{knope, p.abuf};
        const int t1 = (NLAT / 256) * 12, t2 = (NTOK / 256) * 16;
        for (int it = blockIdx.x; it < t1 + t2; it += gridDim.x) {
            if (it < t1) gemm_tile<4, true>(gq, it / 12, it % 12, eq, smem);
            else { const int i2 = it - t1; gemm_tile<4, true>(gk, i2 / 16, i2 % 16, ek, smem); }
        }
    } break;
    case 14: if ((PHASE_MASK >> 14) & 1) attn_phase(p, qbuf, knope, p.abuf, obuf, smem); break;
    case 15: if ((PHASE_MASK >> 15) & 1) { GemmDesc g{obuf, DM, p.wt_mla_out, 1024, 0}; EpiResid e{p.hctx, p.out, p.hctx, p.out, p.ada + (size_t)5 * 6144 + 2 * 1024, NCTX}; gemm_phase<4, false>(g, NLAT / 256, 8, e, smem); } break;
    case 16: if ((PHASE_MASK >> 16) & 1) norm_mod_phase(p, 1, 1, 3, NCTX, NTOK); break;
    case 17: if ((PHASE_MASK >> 17) & 1) { GemmDesc g{p.abuf + (size_t)NCTX * DM, DM, p.wt_f1_1, 1024, 0}; EpiSwiglu e{hmid}; gemm_phase_tail2(g, NLAT / 256, 44, e, smem); } break;
    case 18: if ((PHASE_MASK >> 18) & 1) { GemmDesc g{hmid, DFF, p.wt_f2_1, DFF, 0}; EpiResid e{p.hctx, p.out, p.hctx, p.out, p.ada + (size_t)5 * 6144 + 5 * 1024, NCTX}; gemm_phase<4, false>(g, NLAT / 256, 8, e, smem); } break;
    case 19: if ((PHASE_MASK >> 19) & 1) final_norm_phase(p); break;
    default: break;
    }
}

constexpr int SMEM_BYTES = (256 + 128) * LDT * 2 + 256 * 4;

__global__ void __launch_bounds__(256, 2) fwd_megakernel(Params p, int ph_lo, int ph_hi) {
    __shared__ __attribute__((aligned(16))) char smem[SMEM_BYTES];
    __shared__ __attribute__((aligned(16))) unsigned xb_words[4];
    cg::grid_group grid = cg::this_grid();
    if (threadIdx.x < 4) xb_words[threadIdx.x] = 0u;
    __syncthreads();
    XcdBarrier xb = xcd_barrier_post(p.bar, xb_words);
    if (ph_hi > 1000) grid.sync();
#ifndef PROBE_DUP
#define PROBE_DUP -1
#endif
#define RUN_PH(N) if (ph_lo <= N && N < ph_hi) { if (N == PROBE_DUP) run_phase(p, N, smem); run_phase(p, N, smem); if (N + 1 < ph_hi) xcd_barrier(xb); }
    RUN_PH(0) RUN_PH(1) RUN_PH(2) RUN_PH(3) RUN_PH(4) RUN_PH(5) RUN_PH(6) RUN_PH(7) RUN_PH(8) RUN_PH(9)
    RUN_PH(10) RUN_PH(11) RUN_PH(12) RUN_PH(13) RUN_PH(14) RUN_PH(15) RUN_PH(16) RUN_PH(17) RUN_PH(18) RUN_PH(19)
#undef RUN_PH
}

extern "C" void kernel_launch(void* const* d_in, const int* in_sizes, int n_in, void* d_out, int out_size, void* d_ws, size_t ws_size, hipStream_t stream) {
    static int grid_blocks = 0;
    if (grid_blocks == 0) {
        int dev = 0, cus = 0, per_cu = 0;
        hipGetDevice(&dev);
        hipDeviceGetAttribute(&cus, hipDeviceAttributeMultiprocessorCount, dev);
        hipOccupancyMaxActiveBlocksPerMultiprocessor(&per_cu, fwd_megakernel, 256, 0);
        if (per_cu < 1) per_cu = 1;
        if (per_cu > 2) per_cu = 2;
        grid_blocks = cus * per_cu;
    }
    Params p{};
    const float* const* in = (const float* const*)d_in;
    p.x = in[0]; p.c = in[1]; p.ctx = in[2]; p.c_ctx = in[3]; p.w_ada = in[4]; p.b_ada = in[5]; p.w_gate = in[6]; p.w_up = in[7]; p.w_down = in[8];
    p.w_in0 = in[9]; p.conv_w = in[10]; p.conv_b = in[11]; p.dt_bias = in[12]; p.a_log = in[13]; p.ssd_d = in[14]; p.ssd_norm_w = in[15];
    p.decay_logit = in[16]; p.gn_w = in[17]; p.w_out0 = in[18]; p.mla_w_in = in[19]; p.q_norm_w = in[20]; p.w_uq = in[21]; p.kv_norm_w = in[22];
    p.w_ukv = in[23]; p.mla_w_out = in[24]; p.final_norm_w = in[25];
    p.out = (float*)d_out;
    char* ws = (char*)d_ws;
    size_t off = 0;
    auto take = [&](size_t bytes) { char* r = ws + off; off += (bytes + 255) & ~(size_t)255; return r; };
    p.wt_in0 = (bf16_t*)take((size_t)3712 * 1024 * 2);
    p.wt_out0 = (bf16_t*)take((size_t)1024 * 1024 * 2);
    p.wt_f1_0 = (bf16_t*)take((size_t)5632 * 1024 * 2);
    p.wt_f2_0 = (bf16_t*)take((size_t)1024 * 2816 * 2);
    p.big = (bf16_t*)take((size_t)NTOK * P0W * 2);
    p.abuf = (bf16_t*)take((size_t)NTOK * 1024 * 2);
    char* states = take((size_t)NITEM / 2 * 2 * 4096 * 2 + (size_t)NITEM / 2 * 2 * 8192 * 2);
    p.st_ret = (bf16_t*)states;
    p.st_ssd = p.st_ret + (size_t)(NITEM / 2) * 2 * 4096;
    {
        char* w1 = states; size_t o1 = 0;
        auto take1 = [&](size_t bytes) { char* r = w1 + o1; o1 += (bytes + 255) & ~(size_t)255; return r; };
        p.wt_mla_in = (bf16_t*)take1((size_t)1152 * 1024 * 2);
        p.wt_uq = (bf16_t*)take1((size_t)1536 * 768 * 2);
        p.wt_ukv = (bf16_t*)take1((size_t)2048 * 256 * 2);
        p.wt_mla_out = (bf16_t*)take1((size_t)1024 * 1024 * 2);
        p.wt_f1_1 = (bf16_t*)take1((size_t)5632 * 1024 * 2);
        p.wt_f2_1 = (bf16_t*)take1((size_t)1024 * 2816 * 2);
    }
    p.hctx = (float*)take((size_t)NCTX * DM * 4);
    p.ada = (float*)take((size_t)2 * 5 * 6144 * 4);
    p.rope_ret = (float*)take(2048 * 4);
    p.rope_mla = (float*)take(1024 * 4);
    p.dt_raw = (float*)take((size_t)NTOK * 16 * 4);
    p.dtv = (float*)take((size_t)NTOK * 16 * 4);
    p.la = (float*)take((size_t)NTOK * 16 * 4);
    p.tot = (float*)take((size_t)NITEM * 2 * 4);
    p.kpe = (bf16_t*)take((size_t)NTOK * 32 * 2);
    p.bar = (unsigned*)take((size_t)XCD_BAR_WORDS * 4);
    if (off > ws_size) { fprintf(stderr, "kernel_launch: workspace too small: need %zu, have %zu\n", off, ws_size); return; }
    for (int f = 0; f < 16; ++f) p.inv_ret[f] = powf(10000.0f, -(float)f / 16.0f);
    for (int f = 0; f < 8; ++f) p.inv_mla[f] = powf(10000.0f, -(float)f / 8.0f);
    hipMemsetAsync(p.bar, 0, (size_t)XCD_BAR_WORDS * 4, stream);
#if SINGLE_LAUNCH
    int lo = 0, hi = NPHASE;
    void* args[] = {&p, &lo, &hi};
    hipError_t e = hipLaunchCooperativeKernel((const void*)fwd_megakernel, dim3(grid_blocks), dim3(256), args, 0, stream);
    if (e != hipSuccess) fprintf(stderr, "cooperative launch failed: %s (grid %d)\n", hipGetErrorString(e), grid_blocks);
#else
    for (int ph = 0; ph < NPHASE; ++ph) hipLaunchKernelGGL(fwd_megakernel, dim3(grid_blocks), dim3(256), 0, stream, p, ph, ph + 1);
#endif
}
```
